# Optimizing an MI355X kernel written in HIP

```python
import math
import jax, jax.numpy as jnp
from jax import lax
import numpy as np

D_MODEL = 2048
BATCH = 2
SEQ = 8192
DEPTH = 1

N_Q_HEADS = 16
N_KV_HEADS = 2
HEAD_DIM = 64
Q_PER_KV = N_Q_HEADS // N_KV_HEADS
WINDOW = 128
BLOCK = 128
ATTN_WIDTH = N_Q_HEADS * HEAD_DIM
KV_WIDTH = N_KV_HEADS * HEAD_DIM
SSM_GROUP = 16
SSM_GROUPS = 32
SSM_WIDTH = SSM_GROUP * SSM_GROUPS
SSM_STATE = 64
DT_MIN = 0.001
DT_MAX = 0.1
D_FF = 5632
CONV_WIDTH = 3
RMS_EPS = 1e-6
IN_COLS = ATTN_WIDTH + 2 * KV_WIDTH + SSM_WIDTH + 2 * D_MODEL
SPLIT_POINTS = (ATTN_WIDTH, ATTN_WIDTH + KV_WIDTH, ATTN_WIDTH + 2 * KV_WIDTH,
                ATTN_WIDTH + 2 * KV_WIDTH + SSM_WIDTH,
                ATTN_WIDTH + 2 * KV_WIDTH + SSM_WIDTH + D_MODEL)
NEG_BIG = -1e30

kernel_name = "hybrid_swa_s5_convffn_block"


def rms_norm(x, g):
    xf = x.astype(jnp.float32)
    y = xf * lax.rsqrt(jnp.mean(xf * xf, axis=-1, keepdims=True) + RMS_EPS)
    return (y * g.astype(jnp.float32)).astype(x.dtype)


def sliding_window_attention(q, k, v, sinks):
    b, l = q.shape[0], q.shape[1]
    nb = l // BLOCK
    qb = q.reshape(b, nb, BLOCK, N_KV_HEADS, Q_PER_KV, HEAD_DIM)
    kb = k.reshape(b, nb, BLOCK, N_KV_HEADS, HEAD_DIM)
    vb = v.reshape(b, nb, BLOCK, N_KV_HEADS, HEAD_DIM)

    def with_prev(t):
        prev = jnp.pad(t, ((0, 0), (1, 0), (0, 0), (0, 0), (0, 0)))[:, :-1]
        return jnp.concatenate([prev, t], axis=2)

    kx = with_prev(kb)
    vx = with_prev(vb)
    scores = jnp.einsum('bnqgrd,bnsgd->bngrqs', qb, kx).astype(jnp.float32) * (HEAD_DIM ** -0.5)
    q_idx = jnp.arange(BLOCK)[:, None]
    s_idx = jnp.arange(2 * BLOCK)[None, :]
    dist = q_idx + BLOCK - s_idx
    band = (dist >= 0) & (dist < WINDOW)
    valid = band[None] & ((jnp.arange(nb)[:, None, None] > 0) | (s_idx[None] >= BLOCK))
    slopes = 2.0 ** (-8.0 * jnp.arange(1, N_Q_HEADS + 1, dtype=jnp.float32) / N_Q_HEADS)
    slopes = slopes.reshape(N_KV_HEADS, Q_PER_KV)
    alibi = -slopes[:, :, None, None] * dist.astype(jnp.float32)[None, None]
    scores = scores + alibi[None, None]
    scores = jnp.where(valid[None, :, None, None], scores, NEG_BIG)
    sink = sinks.astype(jnp.float32).reshape(N_KV_HEADS, Q_PER_KV)[None, None, :, :, None, None]
    m = jnp.maximum(jnp.max(scores, axis=-1, keepdims=True), sink)
    p = jnp.exp(scores - m)
    p = p / (jnp.sum(p, axis=-1, keepdims=True) + jnp.exp(sink - m))
    out = jnp.einsum('bngrqs,bnsgd->bnqgrd', p.astype(v.dtype), vx)
    return out.reshape(b, l, ATTN_WIDTH)


def s5_ssm(u, a_re, a_im, log_dt, b_re, b_im, c_re, c_im, d_skip):
    bsz, l = u.shape[0], u.shape[1]
    ug = u.reshape(bsz, l, SSM_GROUPS, SSM_GROUP)
    dt = jnp.exp(log_dt)[:, None]
    mag = jnp.exp(a_re * dt)
    ab_re = mag * jnp.cos(a_im * dt)
    ab_im = mag * jnp.sin(a_im * dt)
    nr = ab_re - 1.0
    ni = ab_im
    den = a_re * a_re + a_im * a_im
    z_re = (nr * a_re + ni * a_im) / den
    z_im = (ni * a_re - nr * a_im) / den
    bb_re = z_re[..., None] * b_re - z_im[..., None] * b_im
    bb_im = z_re[..., None] * b_im + z_im[..., None] * b_re
    bu_re = jnp.einsum('gph,blgh->blgp', bb_re, ug)
    bu_im = jnp.einsum('gph,blgh->blgp', bb_im, ug)
    a_re_t = jnp.broadcast_to(ab_re, bu_re.shape)
    a_im_t = jnp.broadcast_to(ab_im, bu_im.shape)

    def combine(left, right):
        a1r, a1i, b1r, b1i = left
        a2r, a2i, b2r, b2i = right
        return (a1r * a2r - a1i * a2i,
                a1r * a2i + a1i * a2r,
                a2r * b1r - a2i * b1i + b2r,
                a2r * b1i + a2i * b1r + b2i)

    _, _, xs_re, xs_im = lax.associative_scan(combine, (a_re_t, a_im_t, bu_re, bu_im), axis=1)
    y = (jnp.einsum('ghp,blgp->blgh', c_re, xs_re)
         - jnp.einsum('ghp,blgp->blgh', c_im, xs_im)
         + d_skip.reshape(SSM_GROUPS, SSM_GROUP) * ug)
    return y.reshape(bsz, l, SSM_WIDTH)


def causal_depthwise_conv(x, w, b):
    l = x.shape[1]
    xp = jnp.pad(x, ((0, 0), (CONV_WIDTH - 1, 0), (0, 0)))
    y = b
    for k in range(CONV_WIDTH):
        y = y + w[k] * xp[:, k:k + l]
    return y


def setup_inputs(seed: int = 0) -> dict:
    key = jax.random.key(seed)
    ks = jax.random.split(key, 24)
    f32 = jnp.float32
    nrm = lambda k, shape, s: jax.random.normal(k, shape, f32) * s
    x = jax.random.normal(ks[0], (BATCH, SEQ, D_MODEL), f32)
    attn_norm_g = 1.0 + nrm(ks[1], (DEPTH, D_MODEL), 0.02)
    w_in = nrm(ks[2], (DEPTH, D_MODEL, IN_COLS), D_MODEL ** -0.5)
    b_in = nrm(ks[3], (DEPTH, IN_COLS), 0.02)
    attn_sinks = nrm(ks[4], (DEPTH, N_Q_HEADS), 0.5)
    ssm_a_re = -0.5 + nrm(ks[5], (DEPTH, SSM_GROUPS, SSM_STATE), 0.01)
    ssm_a_im = (jnp.pi * jnp.arange(SSM_STATE, dtype=f32))[None, None, :] + nrm(ks[6], (DEPTH, SSM_GROUPS, SSM_STATE), 0.01)
    ssm_log_dt = jax.random.uniform(ks[7], (DEPTH, SSM_GROUPS), f32, minval=math.log(DT_MIN), maxval=math.log(DT_MAX))
    ssm_b_re = nrm(ks[8], (DEPTH, SSM_GROUPS, SSM_STATE, SSM_GROUP), (2 * SSM_GROUP) ** -0.5)
    ssm_b_im = nrm(ks[9], (DEPTH, SSM_GROUPS, SSM_STATE, SSM_GROUP), (2 * SSM_GROUP) ** -0.5)
    ssm_c_re = nrm(ks[10], (DEPTH, SSM_GROUPS, SSM_GROUP, SSM_STATE), (2 * SSM_STATE) ** -0.5)
    ssm_c_im = nrm(ks[11], (DEPTH, SSM_GROUPS, SSM_GROUP, SSM_STATE), (2 * SSM_STATE) ** -0.5)
    ssm_d = nrm(ks[12], (DEPTH, SSM_WIDTH), 1.0)
    w_glu = nrm(ks[13], (DEPTH, SSM_WIDTH, 2 * SSM_WIDTH), SSM_WIDTH ** -0.5)
    b_glu = nrm(ks[14], (DEPTH, 2 * SSM_WIDTH), 0.02)
    w_branch_attn = nrm(ks[15], (DEPTH, ATTN_WIDTH, D_MODEL), ATTN_WIDTH ** -0.5)
    w_branch_ssm = nrm(ks[16], (DEPTH, SSM_WIDTH, D_MODEL), SSM_WIDTH ** -0.5)
    w_out = nrm(ks[17], (DEPTH, D_MODEL, D_MODEL), D_MODEL ** -0.5)
    ffn_norm_g = 1.0 + nrm(ks[18], (DEPTH, D_MODEL), 0.02)
    w_up = nrm(ks[19], (DEPTH, D_MODEL, 2 * D_FF), D_MODEL ** -0.5)
    conv_w = nrm(ks[20], (DEPTH, CONV_WIDTH, D_FF), CONV_WIDTH ** -0.5)
    conv_b = nrm(ks[21], (DEPTH, D_FF), 0.02)
    w_down = nrm(ks[22], (DEPTH, D_FF, D_MODEL), D_FF ** -0.5)
    final_norm_g = 1.0 + nrm(ks[23], (D_MODEL,), 0.02)
    return {"x": x, "attn_norm_g": attn_norm_g, "w_in": w_in, "b_in": b_in, "attn_sinks": attn_sinks,
            "ssm_a_re": ssm_a_re, "ssm_a_im": ssm_a_im, "ssm_log_dt": ssm_log_dt,
            "ssm_b_re": ssm_b_re, "ssm_b_im": ssm_b_im, "ssm_c_re": ssm_c_re, "ssm_c_im": ssm_c_im,
            "ssm_d": ssm_d, "w_glu": w_glu, "b_glu": b_glu, "w_branch_attn": w_branch_attn,
            "w_branch_ssm": w_branch_ssm, "w_out": w_out, "ffn_norm_g": ffn_norm_g, "w_up": w_up,
            "conv_w": conv_w, "conv_b": conv_b, "w_down": w_down, "final_norm_g": final_norm_g}


def reference(x, attn_norm_g, w_in, b_in, attn_sinks, ssm_a_re, ssm_a_im, ssm_log_dt, ssm_b_re, ssm_b_im,
              ssm_c_re, ssm_c_im, ssm_d, w_glu, b_glu, w_branch_attn, w_branch_ssm, w_out, ffn_norm_g,
              w_up, conv_w, conv_b, w_down, final_norm_g):
    bsz, seq = x.shape[0], x.shape[1]
    for i in range(DEPTH):
        h = rms_norm(x, attn_norm_g[i])
        proj = h @ w_in[i] + b_in[i]
        q, k, v, u, gate_attn, gate_ssm = jnp.split(proj, SPLIT_POINTS, axis=-1)
        q = q.reshape(bsz, seq, N_Q_HEADS, HEAD_DIM)
        k = k.reshape(bsz, seq, N_KV_HEADS, HEAD_DIM)
        v = v.reshape(bsz, seq, N_KV_HEADS, HEAD_DIM)
        attn = sliding_window_attention(q, k, v, attn_sinks[i])
        y = s5_ssm(u, ssm_a_re[i], ssm_a_im[i], ssm_log_dt[i], ssm_b_re[i], ssm_b_im[i],
                   ssm_c_re[i], ssm_c_im[i], ssm_d[i])
        y_val, y_gate = jnp.split(jax.nn.gelu(y, approximate=False) @ w_glu[i] + b_glu[i], 2, axis=-1)
        ssm = y_val * jax.nn.sigmoid(y_gate)
        merged = (jax.nn.sigmoid(gate_attn) * (attn @ w_branch_attn[i])
                  + jax.nn.sigmoid(gate_ssm) * (ssm @ w_branch_ssm[i]))
        x = x + merged @ w_out[i]
        h = rms_norm(x, ffn_norm_g[i])
        val, gate = jnp.split(h @ w_up[i], 2, axis=-1)
        gate = causal_depthwise_conv(gate, conv_w[i], conv_b[i])
        x = x + (val * jax.nn.gelu(gate, approximate=False)) @ w_down[i]
    return rms_norm(x, final_norm_g)
```

```cpp
#include <hip/hip_runtime.h>
#include <hip/hip_cooperative_groups.h>
#include <cstdio>
#include <cstdint>
namespace cg = cooperative_groups;
namespace pg8 {
#define PG8_LAS __attribute__((address_space(3)))
typedef unsigned short bf16_t;
typedef short bf16x8 __attribute__((ext_vector_type(8)));
typedef float f32x4 __attribute__((ext_vector_type(4)));
typedef unsigned u32x4 __attribute__((ext_vector_type(4)));
constexpr int BM = 256, BK = 64, HALF = 128, HTB = HALF * BK * 2  , STAGE_BYTES = 8 * HTB, NXCD = 8, WGM = 8;

__host__ __device__ __forceinline__ int lds_byte(int r, int c) { const int st = (r >> 4) * 2 + (c >> 5), rr = r & 15, cc = c & 31, ob = rr * 64 + cc * 2; return st * 1024 + (ob ^ (((ob >> 9) & 1) << 5)); }
__host__ __device__ __forceinline__ void stage_rc(int b, int& R, int& C) { const int st = b / 1024, sb = b % 1024, swz = sb ^ (((sb >> 9) & 1) << 5); R = (st >> 1) * 16 + swz / 64; C = (st & 1) * 32 + (swz % 64) / 2; }
__host__ __device__ __forceinline__ int perm32(int rho) { const int n = rho >> 4, i = rho & 15; return 8 * (i >> 2) + 4 * n + (i & 3); }

struct Unit { int pm, pn, rep; };
struct Gemm { const bf16_t* A; const bf16_t* Bt; int M, N, K; };

struct StaticOrder {
    int nM, nN, nwg, G, c, wgm;
    __host__ __device__ void init(int M, int N, int G_, int c_) { nM = M / BM; nN = N / BM; nwg = nM * nN; G = G_; c = c_; wgm = WGM; }
    __host__ __device__ bool next(int i, Unit& u) const {
        const long L = (long)i * G + c; if (L >= nwg) return false;
        int wgid = (int)L; { const int q = nwg / NXCD, r = nwg % NXCD, xcd = wgid % NXCD, off = wgid / NXCD; wgid = (xcd < r ? xcd * (q + 1) : r * (q + 1) + (xcd - r) * q) + off; }
        const int nig = wgm * nN, gid = wgid / nig, fm = gid * wgm, gsz = (nM - fm) < wgm ? (nM - fm) : wgm;
        u.pm = fm + ((wgid % nig) % gsz); u.pn = (wgid % nig) / gsz; return true;
    }
    __device__ __forceinline__ void a_ready(const Unit&) const {}
    __device__ __forceinline__ void done(const Unit&) const {}
};

__device__ __forceinline__ unsigned cvt_pk_bf16(float lo, float hi) { unsigned r; asm volatile("v_cvt_pk_bf16_f32 %0, %1, %2" : "=v"(r) : "v"(lo), "v"(hi)); return r; }
typedef float f32x2 __attribute__((ext_vector_type(2)));
__device__ __forceinline__ f32x2 gelu_pk(f32x2 v) {
    const f32x2 av = __builtin_elementwise_abs(v), d = av * 0.2316418882f + 1.0f;
    f32x2 t; t.x = __builtin_amdgcn_rcpf(d.x); t.y = __builtin_amdgcn_rcpf(d.y);
    f32x2 q = t * 0.5307027145f + (-0.7265760135f); q = q * t + 0.7107068705f; q = q * t + (-0.142248368f); q = q * t + 0.127414796f; q = q * t;
    const f32x2 s = (v * v) * (-0.72134752044f);
    f32x2 e; e.x = __builtin_amdgcn_exp2f(s.x); e.y = __builtin_amdgcn_exp2f(s.y);
    const f32x2 m = v * (q * e), r = v - m;
    f32x2 o; o.x = v.x < 0.f ? m.x : r.x; o.y = v.y < 0.f ? m.y : r.y; return o;
}

template <int ACT  > struct EpiBf16 {
    static constexpr bool PERM = true, AFTER_DRAIN = false; static_assert(ACT == 0 || ACT == 1, "EpiBf16: ACT is 0 (none) or 1 (gelu_pk)");
    bf16_t* O; int ldc; const float* bias; int split_cols; size_t split_stride; float scale0;
    __device__ __forceinline__ void operator()(const f32x4 (&acc)[2][2][4][2], const Unit& u, int wr, int wc, int fr, int fq) const {
        const int row0 = u.pm * BM + wr * 64 + fr; int colt = u.pn * BM; bf16_t* base = O;
        float sc = 1.f; if (split_cols) { const int t = colt / split_cols; base += (size_t)t * split_stride; colt -= t * split_cols; if (t == 0) sc = scale0; }
        const int col0 = colt + wc * 32 + 8 * fq, bcol0 = u.pn * BM + wc * 32 + 8 * fq;
        f32x4 bv[2][2];
#pragma unroll
        for (int bj = 0; bj < 2; ++bj)
#pragma unroll
            for (int n = 0; n < 2; ++n) bv[bj][n] = bias ? *(const f32x4*)(bias + bcol0 + bj * HALF + 4 * n) : (f32x4){0.f, 0.f, 0.f, 0.f};
#pragma unroll
        for (int ai = 0; ai < 2; ++ai)
#pragma unroll
            for (int m = 0; m < 4; ++m) { bf16_t* rowp = base + (size_t)(row0 + ai * HALF + m * 16) * ldc + col0;
#pragma unroll
                for (int bj = 0; bj < 2; ++bj) { f32x4 v0 = acc[ai][bj][m][0] + bv[bj][0], v1 = acc[ai][bj][m][1] + bv[bj][1];
                    if (ACT == 1) { f32x2 a = gelu_pk((f32x2){v0[0], v0[1]}), b = gelu_pk((f32x2){v0[2], v0[3]}), c = gelu_pk((f32x2){v1[0], v1[1]}), d = gelu_pk((f32x2){v1[2], v1[3]});
                        v0 = (f32x4){a.x, a.y, b.x, b.y}; v1 = (f32x4){c.x, c.y, d.x, d.y}; }
                    v0 = v0 * sc; v1 = v1 * sc; u32x4 w; w.x = cvt_pk_bf16(v0[0], v0[1]); w.y = cvt_pk_bf16(v0[2], v0[3]); w.z = cvt_pk_bf16(v1[0], v1[1]); w.w = cvt_pk_bf16(v1[2], v1[3]);
                    *(u32x4*)(rowp + bj * HALF) = w; } }
    }
};

template <class Epi, class Sched, bool ALIGN_EPI = false, bool SP2 = false>
__device__ __forceinline__ void gemm_phase(PG8_LAS unsigned char* lds, const Gemm g, const Sched& S, const Epi& E) {
    const int tid = threadIdx.x, wid = __builtin_amdgcn_readfirstlane(tid >> 6), lane = tid & 63, wr = wid >> 2, wc = wid & 3, fr = lane & 15, fq = lane >> 4;
    const int K = g.K, nt = K / BK;
    unsigned voffA[2], voffB[2];
#pragma unroll
    for (int i = 0; i < 2; ++i) { int R, C; stage_rc(tid * 16 + i * 8192, R, C); const int Rb = Epi::PERM ? ((R & ~31) + perm32(R & 31)) : R;
        voffA[i] = (unsigned)(R * K + C) * 2u; voffB[i] = (unsigned)(Rb * K + C) * 2u; }
    const size_t kstep = (size_t)(BK * 2);
    const size_t hstep = (size_t)HALF * K * 2;
    const size_t tstep = 2 * hstep;
    const unsigned ldsw = (unsigned)wid * 1024u;
    const int aoff = lds_byte(wr * 64 + fr, fq * 8), boff = lds_byte(wc * 32 + fr, fq * 8);
#define PG8_SA(b, h) (((b) * 2 + (h)) * HTB)
#define PG8_SB(b, h) ((4 + (b) * 2 + (h)) * HTB)
#define PG8_STAGE(bufoff, gbase, voff) do { _Pragma("unroll") for (int _i = 0; _i < 2; ++_i) \
        __builtin_amdgcn_global_load_lds((const unsigned*)((const char*)(gbase) + (voff)[_i]), (PG8_LAS unsigned*)(lds + (bufoff) + ldsw + _i * 8192), 16, 0, 0); } while (0)
#define PG8_LDA(dst, b, h) do { _Pragma("unroll") for (int m = 0; m < 4; ++m) _Pragma("unroll") for (int k = 0; k < 2; ++k) dst[m][k] = *(const PG8_LAS bf16x8*)(lds + PG8_SA(b, h) + aoff + m * 2048 + k * 1024); } while (0)
#define PG8_LDB(dst, b, h) do { _Pragma("unroll") for (int n = 0; n < 2; ++n) _Pragma("unroll") for (int k = 0; k < 2; ++k) dst[n][k] = *(const PG8_LAS bf16x8*)(lds + PG8_SB(b, h) + boff + n * 2048 + k * 1024); } while (0)
#define PG8_MMA(ai, bj, At, Bt) do { __builtin_amdgcn_s_setprio(1); _Pragma("unroll") for (int m = 0; m < 4; ++m) _Pragma("unroll") for (int n = 0; n < 2; ++n) _Pragma("unroll") for (int k = 0; k < 2; ++k) \
        acc[ai][bj][m][n] = __builtin_amdgcn_mfma_f32_16x16x32_bf16(Bt[n][k], At[m][k], acc[ai][bj][m][n], 0, 0, 0); __builtin_amdgcn_s_setprio(0); } while (0)
#define PG8_WAIT_V(n) asm volatile("s_waitcnt vmcnt(" #n ")" ::: "memory")
#define PG8_WAIT_L(n) asm volatile("s_waitcnt lgkmcnt(" #n ")" ::: "memory")
#define PG8_BAR __builtin_amdgcn_s_barrier()
#define PG8_SCHED __builtin_amdgcn_sched_barrier(0)
    Unit cur, nxt; int ui = 0;
    if (!S.next(0, cur)) return;
    f32x4 acc[2][2][4][2];
#pragma unroll
    for (int a = 0; a < 2; ++a)
#pragma unroll
        for (int b = 0; b < 2; ++b)
#pragma unroll
            for (int m = 0; m < 4; ++m)
#pragma unroll
                for (int n = 0; n < 2; ++n) acc[a][b][m][n] = (f32x4){0.f, 0.f, 0.f, 0.f};
    bf16x8 At[4][2], B0[2][2], B1[2][2];
    const char* cA = (const char*)g.A + (size_t)cur.pm * tstep; const char* cB = (const char*)g.Bt + (size_t)cur.pn * tstep;
    S.a_ready(cur);
    if constexpr (SP2) {
        PG8_STAGE(PG8_SB(0, 0), cB, voffB); PG8_STAGE(PG8_SB(0, 1), cB + hstep, voffB); PG8_STAGE(PG8_SA(0, 0), cA, voffA); PG8_STAGE(PG8_SA(0, 1), cA + hstep, voffA);
        if (wr == 1) PG8_BAR;
        PG8_WAIT_V(2); PG8_BAR;
        PG8_STAGE(PG8_SB(1, 0), cB + kstep, voffB); PG8_STAGE(PG8_SA(1, 0), cA + kstep, voffA); PG8_STAGE(PG8_SB(1, 1), cB + hstep + kstep, voffB);
        PG8_WAIT_V(6); PG8_BAR;
    } else {
        PG8_STAGE(PG8_SB(0, 0), cB, voffB); PG8_STAGE(PG8_SA(0, 0), cA, voffA); PG8_STAGE(PG8_SB(0, 1), cB + hstep, voffB); PG8_STAGE(PG8_SA(0, 1), cA + hstep, voffA);
        if (wr == 1) PG8_BAR;
        PG8_WAIT_V(4); PG8_BAR;
        PG8_STAGE(PG8_SB(1, 0), cB + kstep, voffB); PG8_STAGE(PG8_SA(1, 0), cA + kstep, voffA); PG8_STAGE(PG8_SB(1, 1), cB + hstep + kstep, voffB);
        PG8_WAIT_V(6); PG8_BAR;
    }
    for (;;) {
        const bool has_next = S.next(ui + 1, nxt);
        const char* nA = has_next ? (const char*)g.A + (size_t)nxt.pm * tstep : cA; const char* nB = has_next ? (const char*)g.Bt + (size_t)nxt.pn * tstep : cB;
        for (int t = 0; t < nt; t += 2) {
            const bool last = (t == nt - 2);
            const char* a1 = cA + (size_t)(t + 1) * kstep;
            const char* a2 = last ? nA : cA + (size_t)(t + 2) * kstep; const char* b2 = last ? nB : cB + (size_t)(t + 2) * kstep;
            const char* a3 = a2 + kstep; const char* b3 = b2 + kstep;
            if (last && has_next) S.a_ready(nxt);
            if constexpr (SP2) {
            PG8_LDB(B0, 0, 0); PG8_LDB(B1, 0, 1); PG8_SCHED; PG8_LDA(At, 0, 0); PG8_STAGE(PG8_SA(1, 1), a1 + hstep, voffA);
            PG8_WAIT_V(8); PG8_WAIT_L(0); PG8_BAR; PG8_MMA(0, 0, At, B0); PG8_MMA(0, 1, At, B1); PG8_BAR; PG8_SCHED;
            PG8_LDA(At, 0, 1); PG8_STAGE(PG8_SB(0, 0), b2, voffB); PG8_STAGE(PG8_SB(0, 1), b2 + hstep, voffB); PG8_STAGE(PG8_SA(0, 0), a2, voffA);
            PG8_WAIT_V(8); PG8_WAIT_L(0); PG8_BAR; PG8_MMA(1, 0, At, B0); PG8_MMA(1, 1, At, B1); PG8_BAR; PG8_SCHED;
            PG8_LDB(B0, 1, 0); PG8_LDB(B1, 1, 1); PG8_SCHED; PG8_LDA(At, 1, 0); PG8_STAGE(PG8_SA(0, 1), a2 + hstep, voffA);
            PG8_WAIT_V(8); PG8_WAIT_L(0); PG8_BAR; PG8_MMA(0, 0, At, B0); PG8_MMA(0, 1, At, B1); PG8_BAR; PG8_SCHED;
            PG8_LDA(At, 1, 1); PG8_STAGE(PG8_SB(1, 0), b3, voffB); PG8_STAGE(PG8_SB(1, 1), b3 + hstep, voffB); PG8_STAGE(PG8_SA(1, 0), a3, voffA);
            PG8_WAIT_V(8); PG8_WAIT_L(0); PG8_BAR; PG8_MMA(1, 0, At, B0); PG8_MMA(1, 1, At, B1); PG8_BAR; PG8_SCHED;
            } else {
            PG8_LDB(B0, 0, 0); PG8_SCHED; PG8_LDA(At, 0, 0); PG8_STAGE(PG8_SA(1, 1), a1 + hstep, voffA);
            PG8_WAIT_L(8); PG8_BAR; PG8_WAIT_L(0); PG8_MMA(0, 0, At, B0); PG8_BAR; PG8_SCHED;
            PG8_LDB(B1, 0, 1); PG8_STAGE(PG8_SB(0, 0), b2, voffB);
            PG8_BAR; PG8_WAIT_L(0); PG8_MMA(0, 1, At, B1); PG8_BAR;
            PG8_LDA(At, 0, 1); PG8_STAGE(PG8_SA(0, 0), a2, voffA);
            PG8_BAR; PG8_WAIT_L(0); PG8_MMA(1, 0, At, B0); PG8_BAR; PG8_SCHED;
            PG8_STAGE(PG8_SB(0, 1), b2 + hstep, voffB);
            PG8_WAIT_V(6); PG8_BAR; PG8_MMA(1, 1, At, B1); PG8_BAR;
            PG8_LDB(B0, 1, 0); PG8_SCHED; PG8_LDA(At, 1, 0); PG8_STAGE(PG8_SA(0, 1), a2 + hstep, voffA);
            PG8_WAIT_L(8); PG8_BAR; PG8_WAIT_L(0); PG8_MMA(0, 0, At, B0); PG8_BAR; PG8_SCHED;
            PG8_LDB(B1, 1, 1); PG8_STAGE(PG8_SB(1, 0), b3, voffB);
            PG8_BAR; PG8_WAIT_L(0); PG8_MMA(0, 1, At, B1); PG8_BAR;
            PG8_LDA(At, 1, 1); PG8_STAGE(PG8_SA(1, 0), a3, voffA);
            PG8_BAR; PG8_WAIT_L(0); PG8_MMA(1, 0, At, B0); PG8_BAR; PG8_SCHED;
            PG8_STAGE(PG8_SB(1, 1), b3 + hstep, voffB);
            PG8_WAIT_V(6); PG8_BAR; PG8_MMA(1, 1, At, B1); PG8_BAR;
            }
        }
        if constexpr (ALIGN_EPI) { if (wr == 0) PG8_BAR; }
        if constexpr (!Epi::AFTER_DRAIN) { E(acc, cur, wr, wc, fr, fq); S.done(cur); }
        if (!has_next) break;
#pragma unroll
        for (int a = 0; a < 2; ++a)
#pragma unroll
            for (int b = 0; b < 2; ++b)
#pragma unroll
                for (int m = 0; m < 4; ++m)
#pragma unroll
                    for (int n = 0; n < 2; ++n) acc[a][b][m][n] = (f32x4){0.f, 0.f, 0.f, 0.f};
        cur = nxt; cA = nA; cB = nB; ++ui;
        if constexpr (ALIGN_EPI) { if (wr == 1) PG8_BAR; }
    }
    PG8_WAIT_V(0);
    if constexpr (!ALIGN_EPI) { if (wr == 0) PG8_BAR; }
    PG8_BAR;
    if constexpr (Epi::AFTER_DRAIN) { E.fused(acc, cur, wr, wc, fr, fq, lds, wid, lane); S.done(cur); }
#undef PG8_SA
#undef PG8_SB
#undef PG8_STAGE
#undef PG8_LDA
#undef PG8_LDB
#undef PG8_MMA
#undef PG8_WAIT_V
#undef PG8_WAIT_L
#undef PG8_BAR
#undef PG8_SCHED
}
}

#ifndef MK_MULTI
#define MK_MULTI 0
#endif
#ifndef MK_REPEAT_MASK
#define MK_REPEAT_MASK 0
#endif
#define REP(k) for (int rep_ = 0; rep_ <= ((MK_REPEAT_MASK >> (k)) & 1); ++rep_)
#define LAS __attribute__((address_space(3)))
typedef unsigned short bf16;
typedef float f32x4 __attribute__((ext_vector_type(4)));
typedef float f32x2 __attribute__((ext_vector_type(2)));
typedef unsigned u32x4 __attribute__((ext_vector_type(4)));
typedef unsigned u32x2 __attribute__((ext_vector_type(2)));
typedef short bf16x8 __attribute__((ext_vector_type(8)));

constexpr int BATCH = 2, SEQ = 8192, DM = 2048, M = BATCH * SEQ;
constexpr int AW = 1024, SWID = 512, DFF = 5632, INC = 5888;
constexpr float EPS = 1e-6f;
constexpr int NPH = 11;
constexpr size_t MiB = 1u << 20;
constexpr size_t WS_RSTD1 = 0, WS_SS2 = 64 * 1024, WS_SS3 = 128 * 1024, WS_LAM = 192 * 1024, WS_LAMT = 208 * 1024, WS_BBAR = 256 * 1024, WS_SLOC = 1 * MiB;
constexpr size_t WS_WIN = 16 * MiB, WS_WGLU = 39 * MiB, WS_WBA = 40 * MiB, WS_WBS = 44 * MiB, WS_WOUT = 46 * MiB, WS_WUP = 54 * MiB, WS_WDN = 98 * MiB;
constexpr size_t WS_XB = 120 * MiB;
constexpr size_t WS_HPREV = 120 * MiB, WS_HG = 132 * MiB, WS_HV = 144 * MiB;
constexpr size_t WS_Q = 184 * MiB, WS_ATT = 216 * MiB, WS_K = 248 * MiB, WS_VT = 252 * MiB, WS_U = 256 * MiB, WS_G = 288 * MiB;
constexpr size_t WS_YG = 416 * MiB, WS_SSM = 432 * MiB, WS_X1B = 448 * MiB, WS_END = 512 * MiB;
constexpr size_t WS_ACT = 184 * MiB;
__device__ unsigned g_ctl[4096];
constexpr int CTL_EXIT = 3520;
constexpr size_t WS_BAR = 768 * 1024;
constexpr int BAR_ZERO_BYTES = 16384;
constexpr int LDS_BYTES = 147456, MISC_OFF = LDS_BYTES - 16;

struct Params { const float* in[24]; float* out; unsigned char* ws; int lo, hi; };

__device__ __forceinline__ float wave_sum(float v) {
#pragma unroll
    for (int o = 1; o < 64; o <<= 1) v += __shfl_xor(v, o);
    return v;
}
typedef __bf16 bf16x2_t __attribute__((ext_vector_type(2)));
__device__ __forceinline__ unsigned pk2(float lo, float hi) { const bf16x2_t r = __builtin_convertvector((f32x2){lo, hi}, bf16x2_t); return __builtin_bit_cast(unsigned, r); }
__device__ __forceinline__ u32x4 pack8(f32x4 a, f32x4 b) { u32x4 w; w.x = pk2(a[0], a[1]); w.y = pk2(a[2], a[3]); w.z = pk2(b[0], b[1]); w.w = pk2(b[2], b[3]); return w; }
__device__ __forceinline__ f32x4 unpk_lo(u32x4 w) { return (f32x4){__uint_as_float(w.x << 16), __uint_as_float(w.x & 0xffff0000u), __uint_as_float(w.y << 16), __uint_as_float(w.y & 0xffff0000u)}; }
__device__ __forceinline__ f32x4 unpk_hi(u32x4 w) { return (f32x4){__uint_as_float(w.z << 16), __uint_as_float(w.z & 0xffff0000u), __uint_as_float(w.w << 16), __uint_as_float(w.w & 0xffff0000u)}; }
__device__ __forceinline__ float sigm(float x) { return __builtin_amdgcn_rcpf(1.f + __builtin_amdgcn_exp2f(-1.4426950408889634f * x)); }
__device__ __forceinline__ float sigmf(float x) { return __builtin_amdgcn_rcpf(1.f + __builtin_amdgcn_exp2f(-1.4426950408889634f * x)); }
__device__ __forceinline__ f32x4 sigm4f(f32x4 v) { return (f32x4){sigmf(v[0]), sigmf(v[1]), sigmf(v[2]), sigmf(v[3])}; }
__device__ __forceinline__ f32x4 sigm4(f32x4 v) { return (f32x4){sigm(v[0]), sigm(v[1]), sigm(v[2]), sigm(v[3])}; }
__device__ __forceinline__ float gelu_exact(float x) { return 0.5f * x * (1.f + erff(x * 0.70710678118654752f)); }
__device__ __forceinline__ f32x4 gelu4(f32x4 v) { pg8::f32x2 a = pg8::gelu_pk((pg8::f32x2){v[0], v[1]}), b = pg8::gelu_pk((pg8::f32x2){v[2], v[3]}); return (f32x4){a.x, a.y, b.x, b.y}; }
#define LDS_WAIT() asm volatile("s_waitcnt lgkmcnt(0)" ::: "memory")

#define XB_TMO      128
#define XB_XCNT(j)  (256  + 64 * (j))
#define XB_XSUB(j)  (1280 + 64 * (j))
#define XB_XGEN(j)  (2304 + 64 * (j))
#define XB_TOP      3328
#define XB_TOPGEN   3392
#define XCD_BAR_WORDS 3456
#define XB_SPIN_CAP (1u << 18)

__device__ __forceinline__ unsigned xb_ld(unsigned* p)              { return __hip_atomic_load(p, __ATOMIC_RELAXED, __HIP_MEMORY_SCOPE_AGENT); }
__device__ __forceinline__ unsigned xb_add(unsigned* p, unsigned v) { return __hip_atomic_fetch_add(p, v, __ATOMIC_RELAXED, __HIP_MEMORY_SCOPE_AGENT); }
__device__ __forceinline__ unsigned xb_xcc_id() { return (unsigned)__builtin_amdgcn_s_getreg((3 << 11) | 20) & 0xFu; }
#define XB_SPIN(cond, bar) do { unsigned _sp = 0; while (cond) { __builtin_amdgcn_s_sleep(1); \
    if ((++_sp & 255u) == 0u) { if (xb_ld(&(bar)[XB_TMO])) break; if (_sp > XB_SPIN_CAP) { atomicAdd(&(bar)[XB_TMO], 1u); break; } } } } while (0)

struct XcdBarrier {
    unsigned* bar; unsigned x;
    volatile LAS unsigned* st;
};

__device__ __forceinline__ XcdBarrier xcd_barrier_post(unsigned* bar, volatile LAS unsigned* st) {
    XcdBarrier b; b.bar = bar; b.x = xb_xcc_id(); b.st = st;
    if (threadIdx.x == 0) (void)xb_add(&bar[XB_XCNT(b.x)], 1u);
    return b;
}
__device__ __forceinline__ void xcd_barrier_complete(unsigned* bar, unsigned x, unsigned& nloc, unsigned& nx) {
    const unsigned G = gridDim.x * gridDim.y * gridDim.z;
    unsigned sum, cnt, mine, sp = 0u;
    for (;;) {
        sum = 0u; cnt = 0u; mine = 0u;
#pragma unroll
        for (unsigned j = 0; j < 16; ++j) { const unsigned c = xb_ld(&bar[XB_XCNT(j)]); sum += c; cnt += (c > 0u) ? 1u : 0u; mine = (j == x) ? c : mine; }
        if (sum == G) break;
        __builtin_amdgcn_s_sleep(1);
        if ((++sp & 255u) == 0u) { if (xb_ld(&bar[XB_TMO])) break; if (sp > XB_SPIN_CAP) { atomicAdd(&bar[XB_TMO], 1u); break; } }
    }
    nloc = mine > 0u ? mine : 1u; nx = cnt > 0u ? cnt : 1u;
}

__device__ __forceinline__ void xcd_barrier(const XcdBarrier& b) {
    asm volatile("s_waitcnt vmcnt(0)" ::: "memory");
    __syncthreads();
    if (threadIdx.x == 0) {
        unsigned* bar = b.bar;
        __builtin_amdgcn_s_waitcnt(0);
        unsigned nloc = b.st[0], nx = b.st[1];
        if (nloc == 0u) { xcd_barrier_complete(bar, b.x, nloc, nx); b.st[0] = nloc; b.st[1] = nx; }
        const unsigned old = xb_add(&bar[XB_XSUB(b.x)], 1u);
        const unsigned gen = old / nloc;
        if (old + 1u == (gen + 1u) * nloc) {
            __builtin_amdgcn_fence(__ATOMIC_RELEASE, "agent");
            asm volatile("s_waitcnt vmcnt(0)" ::: "memory");
            const unsigned og = xb_add(&bar[XB_TOP], 1u);
            const unsigned tg = og / nx;
            if (og + 1u == (tg + 1u) * nx) xb_add(&bar[XB_TOPGEN], 1u);
            else XB_SPIN(xb_ld(&bar[XB_TOPGEN]) == tg, bar);
            __builtin_amdgcn_fence(__ATOMIC_ACQUIRE, "agent");
            xb_add(&bar[XB_XGEN(b.x)], 1u);
            asm volatile("s_waitcnt vmcnt(0)" ::: "memory");
        } else {
            XB_SPIN(xb_ld(&bar[XB_XGEN(b.x)]) == gen, bar);
            __builtin_amdgcn_fence(__ATOMIC_ACQUIRE, "agent");
            asm volatile("s_waitcnt vmcnt(0)" ::: "memory");
        }
    }
    __syncthreads();
}

__device__ __forceinline__ void tr_tile(const float* __restrict__ W, int K, int N, bf16* __restrict__ WT, int k0, int n0, int drow0, const float* __restrict__ gs, LAS float* scr, int lane) {
    const int q = lane & 15, rr = lane >> 4;
    f32x4 v[16];
#pragma unroll
    for (int i = 0; i < 16; ++i) v[i] = __builtin_nontemporal_load((const f32x4*)(W + (size_t)(k0 + 4 * i + rr) * N + n0 + 4 * q));
#pragma unroll
    for (int i = 0; i < 16; ++i) { const int kk = 4 * i + rr; const float s = gs ? gs[k0 + kk] : 1.f; LAS float* d = scr + kk * 65 + 4 * q;
        d[0] = v[i][0] * s; d[1] = v[i][1] * s; d[2] = v[i][2] * s; d[3] = v[i][3] * s; }
    LDS_WAIT();
    const int c = lane & 7, nn = lane >> 3;
#pragma unroll
    for (int j = 0; j < 8; ++j) { const int n = 8 * j + nn; const LAS float* s = scr + (8 * c) * 65 + n;
        u32x4 o; o.x = pk2(s[0], s[65]); o.y = pk2(s[2 * 65], s[3 * 65]); o.z = pk2(s[4 * 65], s[5 * 65]); o.w = pk2(s[6 * 65], s[7 * 65]);
        *(u32x4*)(WT + (size_t)(drow0 + n) * K + k0 + 8 * c) = o; }
    LDS_WAIT();
}
__device__ __forceinline__ void tr_item(const float* __restrict__ W, int K, int N, bf16* __restrict__ WT, int mode, const float* __restrict__ gs, LAS float* scr, int item, int lane) {
    const int nblk = N / 64, kb = item / nblk, nb = item % nblk, k0 = 64 * kb, n0 = 64 * nb;
    int drow0 = n0;
    if (mode) { const int half = N >> 1, bj = n0 >= half ? 1 : 0, cc = n0 - bj * half; drow0 = 256 * (cc >> 7) + 128 * bj + (cc & 127); }
    tr_tile(W, K, N, WT, k0, n0, drow0, gs, scr, lane);
}

__device__ __forceinline__ void p0_prologue(const Params& p, LAS unsigned char* lds, int tid, int wave, int lane, int G) {
    unsigned char* ws = p.ws;
    LAS float* scr = (LAS float*)(lds + wave * 16640);
    const int gw = blockIdx.x * 8 + wave, NGW = G * 8;
    constexpr int I0 = (2048 / 64) * (INC / 64), I1 = (512 / 64) * (1024 / 64), I2 = (1024 / 64) * (2048 / 64), I3 = (512 / 64) * (2048 / 64), I4 = (2048 / 64) * (2048 / 64),
                  I5 = (2048 / 64) * (2 * DFF / 64), I6 = (DFF / 64) * (2048 / 64);
    for (int it = gw; it < I0 + I4 + I2 + I3 + I1; it += NGW) {
        int r = it;
        if (r < I0) { tr_item(p.in[2], 2048, INC, (bf16*)(ws + WS_WIN), 0, p.in[1], scr, r, lane); continue; } r -= I0;
        if (r < I4) { tr_item(p.in[17], 2048, 2048, (bf16*)(ws + WS_WOUT), 0, nullptr, scr, r, lane); continue; } r -= I4;
        if (r < I2) { tr_item(p.in[15], 1024, 2048, (bf16*)(ws + WS_WBA), 0, nullptr, scr, r, lane); continue; } r -= I2;
        if (r < I3) { tr_item(p.in[16], 512, 2048, (bf16*)(ws + WS_WBS), 0, nullptr, scr, r, lane); continue; } r -= I3;
        tr_item(p.in[13], 512, 1024, (bf16*)(ws + WS_WGLU), 1, nullptr, scr, r, lane);
    }
    const float* x = p.in[0]; bf16* XB = (bf16*)(ws + WS_XB); float* rstd1 = (float*)(ws + WS_RSTD1);
    for (int m = gw; m < M; m += NGW) {
        const f32x4* xr = (const f32x4*)(x + (size_t)m * DM) + lane;
        f32x4 v[8]; float ss = 0.f;
#pragma unroll
        for (int j = 0; j < 8; ++j) { v[j] = __builtin_nontemporal_load(xr + 64 * j); ss += (v[j][0] * v[j][0] + v[j][1] * v[j][1]) + (v[j][2] * v[j][2] + v[j][3] * v[j][3]); }
        ss = wave_sum(ss);
        if (lane == 0) rstd1[m] = rsqrtf(ss * (1.f / DM) + EPS);
        u32x2* o = (u32x2*)(XB + (size_t)m * DM) + lane;
#pragma unroll
        for (int j = 0; j < 8; ++j) { u32x2 w; w.x = pk2(v[j][0], v[j][1]); w.y = pk2(v[j][2], v[j][3]); o[64 * j] = w; }
    }
    { float* z2 = (float*)(ws + WS_SS2); float* z3 = (float*)(ws + WS_SS3);
      for (int i = blockIdx.x * 512 + tid; i < M; i += G * 512) { z2[i] = 0.f; z3[i] = 0.f; } }
    { const int gt = blockIdx.x * 512 + tid;
      if (gt < 2048) {
        const int g = gt >> 6;
        const float dt = expf(p.in[7][g]); const float ar = p.in[5][gt], ai = p.in[6][gt];
        const float em1 = expm1f(ar * dt), mag = em1 + 1.f; const float th = ai * dt;
        const float sn = sinf(th), cs = cosf(th), sh = sinf(0.5f * th);
        const float lr = mag * cs, li = mag * sn;
        const float nr = em1 * cs - 2.f * sh * sh, ni = li;
        const float den = ar * ar + ai * ai;
        const float zr = (nr * ar + ni * ai) / den, zi = (ni * ar - nr * ai) / den;
        f32x2* Bb = (f32x2*)(ws + WS_BBAR) + (size_t)gt * 16;
#pragma unroll
        for (int h = 0; h < 16; ++h) { const float br = p.in[8][(size_t)gt * 16 + h], bi = p.in[9][(size_t)gt * 16 + h]; Bb[h] = (f32x2){zr * br - zi * bi, zr * bi + zi * br}; }
        ((f32x2*)(ws + WS_LAM))[gt] = (f32x2){lr, li};
        float pr = lr, pi = li;
#pragma unroll
        for (int s = 0; s < 8; ++s) { const float nr2 = pr * pr - pi * pi, ni2 = 2.f * pr * pi; pr = nr2; pi = ni2; }
        ((f32x2*)(ws + WS_LAMT))[gt] = (f32x2){pr, pi};
      } }
}

#define EPI_ROW(ai, m) (u.pm * 256 + (ai) * 128 + wr * 64 + (m) * 16 + fr)
#define EPI_COL(bj) (u.pn * 256 + (bj) * 128 + wc * 32 + 8 * fq)
typedef pg8::f32x4 ACC_T[2][2][4][2];
struct RepOrder : pg8::StaticOrder {
    int reps;
    __device__ __forceinline__ bool next(int i, pg8::Unit& u) const { const int n = (nwg - c + G - 1) / G; if (n <= 0 || i >= reps * n) return false; u.rep = i / n; return pg8::StaticOrder::next(i % n, u); }
};
#define REPS(k) (1 + ((MK_REPEAT_MASK >> (k)) & 1))

struct EpiIn {
    static constexpr bool PERM = true, AFTER_DRAIN = false;
    const float* rstd; const float* bias; bf16* Q; bf16* K; bf16* VT; float* U; bf16* G;
    __device__ __forceinline__ void operator()(const ACC_T& acc, const pg8::Unit& u, int wr, int wc, int fr, int fq) const {
        const int pn = u.pn;
        f32x4 bv[2][2];
#pragma unroll
        for (int bj = 0; bj < 2; ++bj) { bv[bj][0] = *(const f32x4*)(bias + EPI_COL(bj)); bv[bj][1] = *(const f32x4*)(bias + EPI_COL(bj) + 4); }
#pragma unroll
        for (int ai = 0; ai < 2; ++ai)
#pragma unroll
            for (int m = 0; m < 4; ++m) { const int row = EPI_ROW(ai, m); const float rs = rstd[row];
#pragma unroll
                for (int bj = 0; bj < 2; ++bj) { const int col = EPI_COL(bj);
                    f32x4 v0 = acc[ai][bj][m][0] * rs + bv[bj][0], v1 = acc[ai][bj][m][1] * rs + bv[bj][1];
                    if (pn < 4) { v0 = v0 * 0.125f; v1 = v1 * 0.125f; *(u32x4*)(Q + (size_t)row * AW + col) = pack8(v0, v1); }
                    else if (pn == 4) {
                        if (bj == 0) *(u32x4*)(K + (size_t)row * 128 + (col - 1024)) = pack8(v0, v1);
                        else { const int c = col - 1152, gg = c >> 6, d = c & 63, bb = row >> 13, t = row & (SEQ - 1);
                            bf16* pp = VT + (size_t)((bb * 2 + gg) * 64 + d) * SEQ + t; const u32x4 w = pack8(v0, v1);
                            pp[0] = (bf16)(w.x & 0xffff); pp[SEQ] = (bf16)(w.x >> 16); pp[2 * SEQ] = (bf16)(w.y & 0xffff); pp[3 * SEQ] = (bf16)(w.y >> 16);
                            pp[4 * SEQ] = (bf16)(w.z & 0xffff); pp[5 * SEQ] = (bf16)(w.z >> 16); pp[6 * SEQ] = (bf16)(w.w & 0xffff); pp[7 * SEQ] = (bf16)(w.w >> 16); }
                    }
                    else if (pn < 7) { float* pp = U + (size_t)row * SWID + (col - 1280); *(f32x4*)pp = v0; *(f32x4*)(pp + 4) = v1; }
                    else { __builtin_nontemporal_store(pack8(sigm4(v0), sigm4(v1)), (u32x4*)(G + (size_t)row * 4096 + (col - 1792))); }
                } }
    }
};
struct EpiGlu {
    static constexpr bool PERM = true, AFTER_DRAIN = false;
    const float* bias; bf16* O;
    __device__ __forceinline__ void operator()(const ACC_T& acc, const pg8::Unit& u, int wr, int wc, int fr, int fq) const {
        const int ch = u.pn * 128 + wc * 32 + 8 * fq;
        const f32x4 bv0 = *(const f32x4*)(bias + ch), bv1 = *(const f32x4*)(bias + ch + 4), bg0 = *(const f32x4*)(bias + 512 + ch), bg1 = *(const f32x4*)(bias + 512 + ch + 4);
#pragma unroll
        for (int ai = 0; ai < 2; ++ai)
#pragma unroll
            for (int m = 0; m < 4; ++m) { const int row = EPI_ROW(ai, m);
                const f32x4 o0 = (acc[ai][0][m][0] + bv0) * sigm4f(acc[ai][1][m][0] + bg0), o1 = (acc[ai][0][m][1] + bv1) * sigm4f(acc[ai][1][m][1] + bg1);
                *(u32x4*)(O + (size_t)row * SWID + ch) = pack8(o0, o1); }
    }
};
struct EpiBrA {
    static constexpr bool PERM = true, AFTER_DRAIN = false;
    const bf16* G; bf16* T;
    __device__ __forceinline__ void operator()(const ACC_T& acc, const pg8::Unit& u, int wr, int wc, int fr, int fq) const {
#pragma unroll
        for (int ai = 0; ai < 2; ++ai)
#pragma unroll
            for (int m = 0; m < 4; ++m) { const int row = EPI_ROW(ai, m);
#pragma unroll
                for (int bj = 0; bj < 2; ++bj) { const int col = EPI_COL(bj); const u32x4 gw = __builtin_nontemporal_load((const u32x4*)(G + (size_t)row * 4096 + col));
                    *(u32x4*)(T + (size_t)row * DM + col) = pack8(unpk_lo(gw) * acc[ai][bj][m][0], unpk_hi(gw) * acc[ai][bj][m][1]); } }
    }
};
struct EpiBrB {
    static constexpr bool PERM = true, AFTER_DRAIN = false;
    const bf16* G; const bf16* T; bf16* O;
    __device__ __forceinline__ void operator()(const ACC_T& acc, const pg8::Unit& u, int wr, int wc, int fr, int fq) const {
#pragma unroll
        for (int ai = 0; ai < 2; ++ai)
#pragma unroll
            for (int m = 0; m < 4; ++m) { const int row = EPI_ROW(ai, m);
#pragma unroll
                for (int bj = 0; bj < 2; ++bj) { const int col = EPI_COL(bj); const u32x4 gw = __builtin_nontemporal_load((const u32x4*)(G + (size_t)row * 4096 + 2048 + col));
                    const u32x4 tw = *(const u32x4*)(T + (size_t)row * DM + col);
                    const f32x4 o0 = unpk_lo(tw) + unpk_lo(gw) * acc[ai][bj][m][0], o1 = unpk_hi(tw) + unpk_hi(gw) * acc[ai][bj][m][1];
                    *(u32x4*)(O + (size_t)row * DM + col) = pack8(o0, o1); } }
    }
};
struct EpiX1 {
    static constexpr bool PERM = true, AFTER_DRAIN = false;
    const float* base; bf16* ob; float* ss;
    __device__ __forceinline__ void operator()(const ACC_T& acc, const pg8::Unit& u, int wr, int wc, int fr, int fq) const {
#pragma unroll
        for (int ai = 0; ai < 2; ++ai)
#pragma unroll
            for (int m = 0; m < 4; ++m) { const int row = EPI_ROW(ai, m); float sq = 0.f;
#pragma unroll
                for (int bj = 0; bj < 2; ++bj) { const int col = EPI_COL(bj); const size_t off = (size_t)row * DM + col;
                    const f32x4 o0 = __builtin_nontemporal_load((const f32x4*)(base + off)) + acc[ai][bj][m][0], o1 = __builtin_nontemporal_load((const f32x4*)(base + off + 4)) + acc[ai][bj][m][1];
                    *(u32x4*)(ob + off) = pack8(o0, o1);
                    sq += (o0[0] * o0[0] + o0[1] * o0[1]) + (o0[2] * o0[2] + o0[3] * o0[3]) + (o1[0] * o1[0] + o1[1] * o1[1]) + (o1[2] * o1[2] + o1[3] * o1[3]); }
                sq += __shfl_xor(sq, 16); sq += __shfl_xor(sq, 32);
                if (fq == 0) atomicAdd(ss + row, sq); }
    }
};
struct EpiX2 {
    static constexpr bool PERM = true, AFTER_DRAIN = false;
    const bf16* base; bf16* ob; float* ss;
    __device__ __forceinline__ void operator()(const ACC_T& acc, const pg8::Unit& u, int wr, int wc, int fr, int fq) const {
#pragma unroll
        for (int ai = 0; ai < 2; ++ai)
#pragma unroll
            for (int m = 0; m < 4; ++m) { const int row = EPI_ROW(ai, m); float sq = 0.f;
#pragma unroll
                for (int bj = 0; bj < 2; ++bj) { const int col = EPI_COL(bj); const size_t off = (size_t)row * DM + col;
                    const u32x4 bw = __builtin_nontemporal_load((const u32x4*)(base + off));
                    const f32x4 o0 = unpk_lo(bw) + acc[ai][bj][m][0], o1 = unpk_hi(bw) + acc[ai][bj][m][1];
                    *(u32x4*)(ob + off) = pack8(o0, o1);
                    sq += (o0[0] * o0[0] + o0[1] * o0[1]) + (o0[2] * o0[2] + o0[3] * o0[3]) + (o1[0] * o1[0] + o1[1] * o1[1]) + (o1[2] * o1[2] + o1[3] * o1[3]); }
                sq += __shfl_xor(sq, 16); sq += __shfl_xor(sq, 32);
                if (fq == 0) atomicAdd(ss + row, sq); }
    }
};
struct EpiUp {
    static constexpr bool PERM = true, AFTER_DRAIN = false;
    const float* ss2; const float* cw; const float* cb; bf16* ACT; float* HP; float* HG; float* HV;
    __device__ __forceinline__ void operator()(const ACC_T& acc, const pg8::Unit& u, int wr, int wc, int fr, int fq) const {
        const int ch0 = u.pn * 128 + wc * 32 + 8 * fq;
#pragma unroll
        for (int ai = 0; ai < 2; ++ai) {
            const int grp = u.pm * 4 + ai * 2 + wr, rowg0 = grp * 64;
            float rs[4];
#pragma unroll
            for (int m = 0; m < 4; ++m) rs[m] = rsqrtf(ss2[rowg0 + 16 * m + fr] * (1.f / DM) + EPS);
#pragma unroll
            for (int n = 0; n < 2; ++n) { const int ch = ch0 + 4 * n;
                const f32x4 w0 = *(const f32x4*)(cw + ch), w1 = *(const f32x4*)(cw + DFF + ch), w2 = *(const f32x4*)(cw + 2 * DFF + ch), bb = *(const f32x4*)(cb + ch);
                f32x4 p1 = (f32x4){0.f, 0.f, 0.f, 0.f}, p2 = p1;
#pragma unroll
                for (int m = 0; m < 4; ++m) {
                    const f32x4 g = acc[ai][1][m][n] * rs[m], v = acc[ai][0][m][n] * rs[m];
                    f32x4 c1, c2;
#pragma unroll
                    for (int e = 0; e < 4; ++e) { const int gi = __float_as_int(g[e]);
                        c1[e] = __int_as_float(__builtin_amdgcn_update_dpp(gi, gi, 0x121, 0xf, 0xf, false)); c2[e] = __int_as_float(__builtin_amdgcn_update_dpp(gi, gi, 0x122, 0xf, 0xf, false)); }
                    const f32x4 g1 = fr >= 1 ? c1 : p1, g2 = fr >= 2 ? c2 : p2;
                    const f32x4 cv = bb + w0 * g2 + w1 * g1 + w2 * g;
                    const f32x4 a = v * gelu4(cv);
                    const int row = rowg0 + 16 * m + fr;
                    if (m > 0 || fr >= 2) { u32x2 w; w.x = pk2(a[0], a[1]); w.y = pk2(a[2], a[3]); *(u32x2*)(ACT + (size_t)row * DFF + ch) = w; }
                    else { *(f32x4*)(HG + (size_t)(grp * 2 + fr) * DFF + ch) = g; *(f32x4*)(HV + (size_t)(grp * 2 + fr) * DFF + ch) = v; }
                    if (m == 3 && fr >= 14) *(f32x4*)(HP + (size_t)(grp * 2 + fr - 14) * DFF + ch) = g;
                    p1 = c1; p2 = c2;
                } }
        }
    }
};

__device__ __forceinline__ void attn_item(const Params& p, LAS unsigned char* lds, int item, int tid, int wave, int lane) {
    unsigned char* ws = p.ws;
    const bf16* Qg = (const bf16*)(ws + WS_Q); const bf16* Kg = (const bf16*)(ws + WS_K); const bf16* VTg = (const bf16*)(ws + WS_VT); bf16* Og = (bf16*)(ws + WS_ATT);
    const int g = item & 1, nb = (item >> 1) & 63, b = item >> 7;
    LAS bf16* Ks = (LAS bf16*)lds;
    LAS bf16* Vs = (LAS bf16*)(lds + 36864);
    const int t0 = nb * 128;
#pragma unroll
    for (int i = 0; i < 4; ++i) { const int idx = tid + 512 * i, r = idx >> 3, c8 = idx & 7;
        int tk = t0 - 128 + r; if (nb == 0 && r < 128) tk = r;
        const u32x4 v = *(const u32x4*)(Kg + (size_t)(b * SEQ + tk) * 128 + g * 64 + c8 * 8);
        *(LAS u32x4*)(Ks + r * 72 + c8 * 8) = v; }
#pragma unroll
    for (int i = 0; i < 4; ++i) { const int idx = tid + 512 * i, d = idx >> 5, c8 = idx & 31;
        int tk = t0 - 128 + c8 * 8; if (nb == 0 && c8 < 16) tk = c8 * 8;
        const u32x4 v = *(const u32x4*)(VTg + (size_t)((b * 2 + g) * 64 + d) * SEQ + tk);
        *(LAS u32x4*)(Vs + d * 264 + c8 * 8) = v; }
    __syncthreads();
    const int head = g * 8 + wave, qn = lane & 15, q4 = lane >> 4;
    const float slope = exp2f(-0.5f * (float)(head + 1)), sink = p.in[4][head];
    float ab[9][4];
#pragma unroll
    for (int j = 0; j < 9; ++j)
#pragma unroll
        for (int r = 0; r < 4; ++r) { const int dist = qn - 4 * q4 - r + 128 - 16 * j; ab[j][r] = (dist >= 0 && dist < 128) ? -slope * (float)dist : -1e30f; }
    bf16x8 nq0, nq1;
    { const bf16* qp = Qg + (size_t)(b * SEQ + t0 + qn) * AW + head * 64 + 8 * q4; nq0 = *(const bf16x8*)qp; nq1 = *(const bf16x8*)(qp + 32); }
    for (int qb = 0; qb < 8; ++qb) {
        const size_t qrow = (size_t)(b * SEQ + t0 + 16 * qb + qn);
        const bf16x8 bq0 = nq0, bq1 = nq1;
        if (qb < 7) { const bf16* qp = Qg + (qrow + 16) * AW + head * 64 + 8 * q4; nq0 = *(const bf16x8*)qp; nq1 = *(const bf16x8*)(qp + 32); }
        f32x4 S[10];
#pragma unroll
        for (int j = 0; j < 9; ++j) { const LAS bf16* kp = Ks + (16 * (qb + j) + qn) * 72 + 8 * q4;
            const bf16x8 a0 = *(const LAS bf16x8*)kp, a1 = *(const LAS bf16x8*)(kp + 32);
            f32x4 s = (f32x4){0.f, 0.f, 0.f, 0.f};
            s = __builtin_amdgcn_mfma_f32_16x16x32_bf16(a0, bq0, s, 0, 0, 0);
            s = __builtin_amdgcn_mfma_f32_16x16x32_bf16(a1, bq1, s, 0, 0, 0);
            S[j] = s; }
        float mx = sink;
        if (nb > 0) {
#pragma unroll
            for (int j = 0; j < 9; ++j)
#pragma unroll
                for (int r = 0; r < 4; ++r) { const float sc = S[j][r] + ab[j][r]; S[j][r] = sc; mx = fmaxf(mx, sc); }
        } else {
            const int qi = 16 * qb + qn;
#pragma unroll
            for (int j = 0; j < 9; ++j)
#pragma unroll
                for (int r = 0; r < 4; ++r) { const int s = 16 * (qb + j) + 4 * q4 + r, dist = qi + 128 - s;
                    const bool valid = (dist >= 0) && (dist < 128) && (s >= 128);
                    const float sc = valid ? (S[j][r] - slope * (float)dist) : -1e30f;
                    S[j][r] = sc; mx = fmaxf(mx, sc); }
        }
        mx = fmaxf(mx, __shfl_xor(mx, 16)); mx = fmaxf(mx, __shfl_xor(mx, 32));
        float sum = 0.f;
#pragma unroll
        for (int j = 0; j < 9; ++j)
#pragma unroll
            for (int r = 0; r < 4; ++r) { const float e = __expf(S[j][r] - mx); S[j][r] = e; sum += e; }
        sum += __shfl_xor(sum, 16); sum += __shfl_xor(sum, 32);
        const float inv = 1.f / (sum + __expf(sink - mx));
        S[9] = (f32x4){0.f, 0.f, 0.f, 0.f};
        f32x4 O[4];
#pragma unroll
        for (int db = 0; db < 4; ++db) O[db] = (f32x4){0.f, 0.f, 0.f, 0.f};
#pragma unroll
        for (int js = 0; js < 5; ++js) {
            const u32x4 pw = pack8(S[2 * js], S[2 * js + 1]);
            const bf16x8 pb = __builtin_bit_cast(bf16x8, pw);
            const int kb0 = qb + 2 * js; int kb1 = kb0 + 1; kb1 = kb1 > 15 ? 15 : kb1;
#pragma unroll
            for (int db = 0; db < 4; ++db) { const LAS bf16* vp = Vs + (16 * db + qn) * 264 + 4 * q4;
                const u32x2 lo = *(const LAS u32x2*)(vp + 16 * kb0), hi = *(const LAS u32x2*)(vp + 16 * kb1);
                const u32x4 aw = (u32x4){lo.x, lo.y, hi.x, hi.y};
                O[db] = __builtin_amdgcn_mfma_f32_16x16x32_bf16(__builtin_bit_cast(bf16x8, aw), pb, O[db], 0, 0, 0); }
        }
        bf16* op = Og + qrow * AW + head * 64 + 4 * q4;
#pragma unroll
        for (int db = 0; db < 4; ++db) { const f32x4 o = O[db] * inv; u32x2 w; w.x = pk2(o[0], o[1]); w.y = pk2(o[2], o[3]); *(u32x2*)(op + 16 * db) = w; }
    }
    __syncthreads();
}

constexpr int DT_UP = (2048 / 64) * (2 * DFF / 64), DT_DN = (DFF / 64) * (2048 / 64);
constexpr int NDEFH = 2 * (DT_UP + DT_DN), NP1 = 6144, NDEFH2 = NP1 + (NDEFH - NP1) / 2;
struct TJob { const float* W; bf16* WT; const float* gs; int K, N, k0, n0, drow0; };
__device__ __forceinline__ TJob def_job(const Params& p, int idx) {
    unsigned char* ws = p.ws; TJob j; int r = idx, mode = 0; j.gs = nullptr;
    if (r < DT_UP) { j.W = p.in[19]; j.WT = (bf16*)(ws + WS_WUP); j.gs = p.in[18]; j.K = 2048; j.N = 2 * DFF; mode = 1; }
    else { r -= DT_UP; j.W = p.in[22]; j.WT = (bf16*)(ws + WS_WDN); j.K = DFF; j.N = 2048; }
    const int nblk = j.N / 64, kb = r / nblk, nb = r - kb * nblk; j.k0 = 64 * kb; j.n0 = 64 * nb; j.drow0 = j.n0;
    if (mode) { const int half = j.N >> 1, bj = j.n0 >= half ? 1 : 0, cc = j.n0 - bj * half; j.drow0 = 256 * (cc >> 7) + 128 * bj + (cc & 127); }
    return j;
}
#define TILE_ISSUE_HALF(p_, idx_, h_, v_) do { const TJob j_ = def_job(p_, idx_); const int q_ = lane & 15, rr_ = lane >> 4; \
        _Pragma("unroll") for (int i_ = 0; i_ < 8; ++i_) v_[i_] = __builtin_nontemporal_load((const f32x4*)(j_.W + (size_t)(j_.k0 + 32 * (h_) + 4 * i_ + rr_) * j_.N + j_.n0 + 4 * q_)); } while (0)
__device__ __forceinline__ void tile_finish_half(const Params& p, int idx, int h, const f32x4* v, LAS float* scr, int lane) {
    asm volatile("" : "+s"(idx));
    const TJob j = def_job(p, idx); const int q = lane & 15, rr = lane >> 4, c = lane & 3, nn = lane >> 2;
#pragma unroll
    for (int i = 0; i < 8; ++i) { const int kk = 4 * i + rr; const float s = j.gs ? j.gs[j.k0 + 32 * h + kk] : 1.f; LAS float* d = scr + kk * 65 + 4 * q; const f32x4 w = v[i];
        d[0] = w[0] * s; d[1] = w[1] * s; d[2] = w[2] * s; d[3] = w[3] * s; }
    LDS_WAIT();
#pragma unroll
    for (int jj = 0; jj < 4; ++jj) { const int n = 16 * jj + nn; const LAS float* s = scr + (8 * c) * 65 + n;
        u32x4 o; o.x = pk2(s[0], s[65]); o.y = pk2(s[2 * 65], s[3 * 65]); o.z = pk2(s[4 * 65], s[5 * 65]); o.w = pk2(s[6 * 65], s[7 * 65]);
        *(u32x4*)(j.WT + (size_t)(j.drow0 + n) * j.K + j.k0 + 32 * h + 8 * c) = o; }
    LDS_WAIT();
}

constexpr int SCH = 256, NCH = SEQ / SCH;
#define SSM_ZSEL(w_) do { if (q4 >= 2) { (w_).x = 0u; (w_).y = 0u; (w_).z = 0u; (w_).w = 0u; } } while (0)
#define SSM_BU16(sb) do { const LAS f32x4* up_ = (const LAS f32x4*)(ub + (16 * (sb) + qn) * 16 + 8 * (q4 & 1)); u32x4 aw_ = pack8(up_[0], up_[1]); \
        aw_.x = q4 < 2 ? aw_.x : 0u; aw_.y = q4 < 2 ? aw_.y : 0u; aw_.z = q4 < 2 ? aw_.z : 0u; aw_.w = q4 < 2 ? aw_.w : 0u; const bf16x8 a_ = __builtin_bit_cast(bf16x8, aw_); \
        f32x4 d_[8]; _Pragma("unroll") for (int kb = 0; kb < 8; ++kb) d_[kb] = __builtin_amdgcn_mfma_f32_16x16x32_bf16(a_, Bq[kb], (f32x4){0.f, 0.f, 0.f, 0.f}, 0, 0, 0); \
        _Pragma("unroll") for (int kb = 0; kb < 8; ++kb) _Pragma("unroll") for (int r = 0; r < 4; ++r) xb[(4 * q4 + r) * 132 + 16 * kb + qn] = d_[kb][r]; } while (0)
#define SSM_BC_LOAD() bf16x8 Bq[8]; do { _Pragma("unroll") for (int kb = 0; kb < 8; ++kb) { \
        const f32x4* bp_ = (const f32x4*)((const f32x2*)(ws + WS_BBAR) + (size_t)(g * 64 + 8 * kb + (qn >> 1)) * 16 + 8 * (q4 & 1)); const f32x4 v0_ = bp_[0], v1_ = bp_[1], v2_ = bp_[2], v3_ = bp_[3]; \
        const bool im_ = qn & 1; const f32x4 lo_ = (f32x4){im_ ? v0_[1] : v0_[0], im_ ? v0_[3] : v0_[2], im_ ? v1_[1] : v1_[0], im_ ? v1_[3] : v1_[2]}, hi_ = (f32x4){im_ ? v2_[1] : v2_[0], im_ ? v2_[3] : v2_[2], im_ ? v3_[1] : v3_[0], im_ ? v3_[3] : v3_[2]}; \
        u32x4 bw_ = pack8(lo_, hi_); bw_.x = q4 < 2 ? bw_.x : 0u; bw_.y = q4 < 2 ? bw_.y : 0u; bw_.z = q4 < 2 ? bw_.z : 0u; bw_.w = q4 < 2 ? bw_.w : 0u; Bq[kb] = __builtin_bit_cast(bf16x8, bw_); } } while (0)
#define SSM_GLOAD(s64) do { const float* up = U + (size_t)(b * SEQ + SCH * c + 64 * (s64) + lane) * SWID + 16 * g; a0 = *(const f32x4*)up; a1 = *(const f32x4*)(up + 4); a2 = *(const f32x4*)(up + 8); a3 = *(const f32x4*)(up + 12); } while (0)
#define SSM_LSTORE() do { LAS f32x4* d = (LAS f32x4*)(ub + lane * 16); d[0] = a0; d[1] = a1; d[2] = a2; d[3] = a3; } while (0)

__device__ __forceinline__ void ssm_pass1(const Params& p, LAS unsigned char* lds, int wave, int lane, int G) {
    unsigned char* ws = p.ws; const float* U = (const float*)(ws + WS_U);
    LAS float* ub = (LAS float*)(lds + wave * 12544);
    LAS float* xb = ub + 1024;
    const int gw = blockIdx.x * 8 + wave, NGW = G * 8, qn = lane & 15, q4 = lane >> 4;
    int tslot = NP1 + gw;
    for (int it = gw; it < BATCH * 32 * NCH; it += NGW) {
        const int c = it & (NCH - 1), g = (it >> 5) & 31, b = it >> 10;
        f32x4 a0, a1, a2, a3;
        SSM_GLOAD(0);
        const f32x2 lam = ((const f32x2*)(ws + WS_LAM))[g * 64 + lane];
        SSM_BC_LOAD();
        float xr = 0.f, xi = 0.f;
#pragma unroll 1
        for (int s64 = 0; s64 < 4; ++s64) {
            SSM_LSTORE();
            if (s64 < 3) SSM_GLOAD(s64 + 1);
            const bool has = tslot < NDEFH2; f32x4 tv[8];
            if (has) TILE_ISSUE_HALF(p, tslot >> 1, tslot & 1, tv);
            LDS_WAIT();
#pragma unroll 1
            for (int sub = 0; sub < 4; ++sub) {
                SSM_BU16(sub);
                LDS_WAIT();
#pragma unroll
                for (int tt = 0; tt < 16; ++tt) { const f32x2 bu = *(const LAS f32x2*)(xb + tt * 132 + 2 * lane);
                    const float nxr = lam.x * xr - lam.y * xi + bu.x, nxi = lam.x * xi + lam.y * xr + bu.y; xr = nxr; xi = nxi; }
                LDS_WAIT();
            }
            if (has) { tile_finish_half(p, tslot >> 1, tslot & 1, tv, xb, lane); tslot += NGW; }
        }
        ((f32x2*)(ws + WS_SLOC))[(size_t)((b * 32 + g) * NCH + c) * 64 + lane] = (f32x2){xr, xi};
    }
    for (; tslot < NDEFH2; tslot += NGW) { f32x4 tv[8]; TILE_ISSUE_HALF(p, tslot >> 1, tslot & 1, tv); tile_finish_half(p, tslot >> 1, tslot & 1, tv, xb, lane); }
}
__device__ __forceinline__ void ssm_pass2(const Params& p, LAS unsigned char* lds, int wave, int lane, int G) {
    unsigned char* ws = p.ws; const float* U = (const float*)(ws + WS_U); bf16* YG = (bf16*)(ws + WS_YG);
    LAS float* ub = (LAS float*)(lds + wave * 12544);
    LAS float* xb = ub + 1024;
    const int gw = blockIdx.x * 8 + wave, NGW = G * 8, qn = lane & 15, q4 = lane >> 4;
    int tslot = NDEFH2 + gw;
    for (int it = gw; it < BATCH * 32 * NCH; it += NGW) {
        const int c = it & (NCH - 1), g = (it >> 5) & 31, b = it >> 10;
        f32x4 a0, a1, a2, a3;
        SSM_GLOAD(0);
        const f32x2 lam = ((const f32x2*)(ws + WS_LAM))[g * 64 + lane], lamT = ((const f32x2*)(ws + WS_LAMT))[g * 64 + lane];
        float xr = 0.f, xi = 0.f;
        { const f32x2* sp = (const f32x2*)(ws + WS_SLOC) + (size_t)((b * 32 + g) * NCH) * 64 + lane;
          f32x2 sv[NCH - 1];
#pragma unroll
          for (int jj = 0; jj < NCH - 1; ++jj) { const int j = c - (NCH - 1) + jj; sv[jj] = j >= 0 ? sp[(size_t)j * 64] : (f32x2){0.f, 0.f}; }
#pragma unroll
          for (int jj = 0; jj < NCH - 1; ++jj) { const float nr = lamT.x * xr - lamT.y * xi + sv[jj].x, ni = lamT.x * xi + lamT.y * xr + sv[jj].y; xr = nr; xi = ni; } }
        SSM_BC_LOAD();
        bf16x8 Cq[4];
        { const float* cre = p.in[10] + (size_t)(g * 16 + qn) * 64; const float* cim = p.in[11] + (size_t)(g * 16 + qn) * 64;
#pragma unroll
          for (int ks = 0; ks < 4; ++ks) { const f32x4 cr = *(const f32x4*)(cre + 16 * ks + 4 * q4), ci = *(const f32x4*)(cim + 16 * ks + 4 * q4);
              Cq[ks] = __builtin_bit_cast(bf16x8, pack8((f32x4){cr[0], -ci[0], cr[1], -ci[1]}, (f32x4){cr[2], -ci[2], cr[3], -ci[3]})); } }
        const float dsk = p.in[12][16 * g + qn];
#pragma unroll 1
        for (int s64 = 0; s64 < 4; ++s64) {
            SSM_LSTORE();
            if (s64 < 3) SSM_GLOAD(s64 + 1);
            const bool has = tslot < NDEFH; f32x4 tv[8];
            if (has) TILE_ISSUE_HALF(p, tslot >> 1, tslot & 1, tv);
            LDS_WAIT();
#pragma unroll 1
            for (int sub = 0; sub < 4; ++sub) {
                SSM_BU16(sub);
                LDS_WAIT();
#pragma unroll
                for (int tt = 0; tt < 16; ++tt) { LAS f32x2* xp = (LAS f32x2*)(xb + tt * 132 + 2 * lane); const f32x2 bu = *xp;
                    const float nxr = lam.x * xr - lam.y * xi + bu.x, nxi = lam.x * xi + lam.y * xr + bu.y; xr = nxr; xi = nxi; *xp = (f32x2){xr, xi}; }
                LDS_WAIT();
                f32x4 d = (f32x4){0.f, 0.f, 0.f, 0.f};
                const LAS f32x4* ap = (const LAS f32x4*)(xb + qn * 132 + 8 * q4);
#pragma unroll
                for (int ks = 0; ks < 4; ++ks) d = __builtin_amdgcn_mfma_f32_16x16x32_bf16(__builtin_bit_cast(bf16x8, pack8(ap[8 * ks], ap[8 * ks + 1])), Cq[ks], d, 0, 0, 0);
                f32x4 yv;
#pragma unroll
                for (int r = 0; r < 4; ++r) yv[r] = d[r] + dsk * ub[(16 * sub + 4 * q4 + r) * 16 + qn];
                const f32x4 ygv = gelu4(yv);
                const unsigned w01 = pk2(ygv[0], ygv[1]), w23 = pk2(ygv[2], ygv[3]);
                bf16* yp = YG + (size_t)(b * SEQ + SCH * c + 64 * s64 + 16 * sub + 4 * q4) * SWID + 16 * g + qn;
                yp[0] = (bf16)(w01 & 0xffffu); yp[SWID] = (bf16)(w01 >> 16); yp[2 * SWID] = (bf16)(w23 & 0xffffu); yp[3 * SWID] = (bf16)(w23 >> 16);
                LDS_WAIT();
            }
            if (has) { tile_finish_half(p, tslot >> 1, tslot & 1, tv, xb, lane); tslot += NGW; }
        }
    }
    for (; tslot < NDEFH; tslot += NGW) { f32x4 tv[8]; TILE_ISSUE_HALF(p, tslot >> 1, tslot & 1, tv); tile_finish_half(p, tslot >> 1, tslot & 1, tv, xb, lane); }
}

__global__ void __launch_bounds__(512) mk_fwd(Params p) {
    extern __shared__ __attribute__((aligned(16))) unsigned char lds_raw[];
    LAS unsigned char* lds = (LAS unsigned char*)lds_raw;
    const int tid = threadIdx.x, lane = tid & 63, wave = __builtin_amdgcn_readfirstlane(tid >> 6), G = gridDim.x;
    unsigned char* ws = p.ws;
    const int lo = p.lo, hi = p.hi;
    volatile LAS unsigned* misc = (volatile LAS unsigned*)(lds + MISC_OFF);
    if (tid < 4) misc[tid] = 0u;
    __syncthreads();
    XcdBarrier xbar; xbar.bar = (unsigned*)g_ctl; xbar.x = 0; xbar.st = misc;
    if (!MK_MULTI) xbar = xcd_barrier_post((unsigned*)g_ctl, misc);
#define IN(k) (lo <= (k) && (k) < hi)
#define SEAM(k) do { if (lo <= (k) && (k) + 1 < hi) xcd_barrier(xbar); } while (0)
    if (IN(0)) { REP(0) { p0_prologue(p, lds, tid, wave, lane, G); } SEAM(0); }
#ifdef MK_EXTRA_SYNCS
    for (int i_ = 0; i_ < MK_EXTRA_SYNCS; ++i_) grid.sync();
#endif
    if (IN(1)) { {
        pg8::Gemm g{(const bf16*)(ws + WS_XB), (const bf16*)(ws + WS_WIN), M, INC, DM}; RepOrder S; S.init(M, INC, G, (int)blockIdx.x); S.reps = REPS(1); S.wgm = 4;
        EpiIn E{(const float*)(ws + WS_RSTD1), p.in[3], (bf16*)(ws + WS_Q), (bf16*)(ws + WS_K), (bf16*)(ws + WS_VT), (float*)(ws + WS_U), (bf16*)(ws + WS_G)};
        pg8::gemm_phase<EpiIn, RepOrder, true, true>(lds, g, S, E);
        { const int nwg = (M / 256) * (INC / 256), rem = nwg % G;
          if (rem != 0 && (int)blockIdx.x >= rem) { const int iw = ((int)blockIdx.x - rem) * 8 + wave, niw = (G - rem) * 8; LAS float* scr = (LAS float*)(lds + wave * 8320);
              for (int h = iw; h < NP1; h += niw) { f32x4 tv[8]; TILE_ISSUE_HALF(p, h >> 1, h & 1, tv); tile_finish_half(p, h >> 1, h & 1, tv, scr, lane); } }
          else if (rem == 0) { const int gw = blockIdx.x * 8 + wave; LAS float* scr = (LAS float*)(lds + wave * 8320);
              for (int h = gw; h < NP1; h += G * 8) { f32x4 tv[8]; TILE_ISSUE_HALF(p, h >> 1, h & 1, tv); tile_finish_half(p, h >> 1, h & 1, tv, scr, lane); } } } }
        SEAM(1);
    }
    if (IN(2)) { REP(2) {
        for (int it = blockIdx.x; it < BATCH * 64 * 2; it += G) attn_item(p, lds, it, tid, wave, lane);
        ssm_pass1(p, lds, wave, lane, G); }
        SEAM(2);
    }
    if (IN(3)) { REP(3) { ssm_pass2(p, lds, wave, lane, G); __syncthreads(); } SEAM(3); }
    if (IN(4)) {
        pg8::Gemm g{(const bf16*)(ws + WS_YG), (const bf16*)(ws + WS_WGLU), M, 1024, SWID}; RepOrder S; S.init(M, 1024, G, (int)blockIdx.x); S.reps = REPS(4);
        EpiGlu E{p.in[14], (bf16*)(ws + WS_SSM)};
        pg8::gemm_phase<EpiGlu, RepOrder, true, true>(lds, g, S, E);
        SEAM(4);
    }
    if (IN(5)) {
        { pg8::Gemm g{(const bf16*)(ws + WS_ATT), (const bf16*)(ws + WS_WBA), M, DM, AW}; RepOrder S; S.init(M, DM, G, (int)blockIdx.x); S.reps = REPS(5); S.wgm = 4;
          EpiBrA E{(const bf16*)(ws + WS_G), (bf16*)(ws + WS_XB)};
          pg8::gemm_phase<EpiBrA, RepOrder, true, true>(lds, g, S, E); }
        __syncthreads();
        { pg8::Gemm g{(const bf16*)(ws + WS_SSM), (const bf16*)(ws + WS_WBS), M, DM, SWID}; RepOrder S; S.init(M, DM, G, (int)blockIdx.x); S.reps = REPS(5); S.wgm = 4;
          EpiBrB E{(const bf16*)(ws + WS_G), (const bf16*)(ws + WS_XB), (bf16*)(ws + WS_XB)};
          pg8::gemm_phase<EpiBrB, RepOrder, true, true>(lds, g, S, E); }
        SEAM(5);
    }
    if (IN(6)) {
        pg8::Gemm g{(const bf16*)(ws + WS_XB), (const bf16*)(ws + WS_WOUT), M, DM, DM}; RepOrder S; S.init(M, DM, G, (int)blockIdx.x); S.reps = REPS(6); S.wgm = 4;
        EpiX1 E{p.in[0], (bf16*)(ws + WS_X1B), (float*)(ws + WS_SS2)};
        pg8::gemm_phase<EpiX1, RepOrder, true, true>(lds, g, S, E);
        SEAM(6);
    }
    if (IN(7)) { {
        pg8::Gemm g{(const bf16*)(ws + WS_X1B), (const bf16*)(ws + WS_WUP), M, 2 * DFF, DM}; RepOrder S; S.init(M, 2 * DFF, G, (int)blockIdx.x); S.reps = REPS(7); S.wgm = 4;
        EpiUp E{(const float*)(ws + WS_SS2), p.in[20], p.in[21], (bf16*)(ws + WS_ACT), (float*)(ws + WS_HPREV), (float*)(ws + WS_HG), (float*)(ws + WS_HV)};
        pg8::gemm_phase<EpiUp, RepOrder, true, true>(lds, g, S, E); }
        SEAM(7);
    }
    if (IN(8)) {
        const float* HP = (const float*)(ws + WS_HPREV); const float* HG = (const float*)(ws + WS_HG); const float* HV = (const float*)(ws + WS_HV);
        const float* cw = p.in[20]; const float* cb = p.in[21]; bf16* ACT = (bf16*)(ws + WS_ACT);
        constexpr int NV = 256 * 2 * (DFF / 4);
        for (int i = blockIdx.x * 512 + tid; i < NV; i += G * 512) {
            const int ch = (i % (DFF / 4)) * 4, rr = i / (DFF / 4), fr = rr & 1, grp = rr >> 1;
            const bool hp = (grp & 127) != 0;
            const f32x4 z = (f32x4){0.f, 0.f, 0.f, 0.f};
            const f32x4 g = *(const f32x4*)(HG + (size_t)(grp * 2 + fr) * DFF + ch), v = *(const f32x4*)(HV + (size_t)(grp * 2 + fr) * DFF + ch);
            const f32x4 pm1 = hp ? *(const f32x4*)(HP + (size_t)((grp - 1) * 2 + 1) * DFF + ch) : z;
            const f32x4 pm2 = hp ? *(const f32x4*)(HP + (size_t)((grp - 1) * 2 + 0) * DFF + ch) : z;
            const f32x4 g0 = *(const f32x4*)(HG + (size_t)(grp * 2) * DFF + ch);
            const f32x4 g1 = fr ? g0 : pm1, g2 = fr ? pm1 : pm2;
            const f32x4 w0 = *(const f32x4*)(cw + ch), w1 = *(const f32x4*)(cw + DFF + ch), w2 = *(const f32x4*)(cw + 2 * DFF + ch), bb = *(const f32x4*)(cb + ch);
            const f32x4 a = v * gelu4(bb + w0 * g2 + w1 * g1 + w2 * g);
            u32x2 w; w.x = pk2(a[0], a[1]); w.y = pk2(a[2], a[3]); *(u32x2*)(ACT + (size_t)(grp * 64 + fr) * DFF + ch) = w;
        }
        SEAM(8);
    }
    if (IN(9)) {
        pg8::Gemm g{(const bf16*)(ws + WS_ACT), (const bf16*)(ws + WS_WDN), M, DM, DFF}; RepOrder S; S.init(M, DM, G, (int)blockIdx.x); S.reps = REPS(9); S.wgm = 4;
        EpiX2 E{(const bf16*)(ws + WS_X1B), (bf16*)(ws + WS_XB), (float*)(ws + WS_SS3)};
        pg8::gemm_phase<EpiX2, RepOrder, true, true>(lds, g, S, E);
        SEAM(9);
    }
    if (IN(10)) {
        const float* ss3 = (const float*)(ws + WS_SS3); const float* gf = p.in[23];
        const int gw = blockIdx.x * 8 + wave, NGW = G * 8;
        f32x4 gv[8];
#pragma unroll
        for (int j = 0; j < 8; ++j) gv[j] = ((const f32x4*)gf)[lane + 64 * j];
        const bf16* X2B = (const bf16*)(ws + WS_XB);
        for (int m = gw; m < M; m += NGW) {
            const float rs = rsqrtf(ss3[m] * (1.f / DM) + EPS);
            const u32x2* xr = (const u32x2*)(X2B + (size_t)m * DM) + lane;
            f32x4* orow = (f32x4*)(p.out + (size_t)m * DM) + lane;
            u32x2 w[8];
#pragma unroll
            for (int j = 0; j < 8; ++j) w[j] = __builtin_nontemporal_load(xr + 64 * j);
#pragma unroll
            for (int j = 0; j < 8; ++j) { const f32x4 v = (f32x4){__uint_as_float(w[j].x << 16), __uint_as_float(w[j].x & 0xffff0000u), __uint_as_float(w[j].y << 16), __uint_as_float(w[j].y & 0xffff0000u)};
                __builtin_nontemporal_store(v * rs * gv[j], orow + 64 * j); }
        }
    }
    if (!MK_MULTI && wave == 0) { unsigned old_ = 0u; if (lane == 0) old_ = xb_add((unsigned*)g_ctl + CTL_EXIT, 1u); old_ = (unsigned)__shfl((int)old_, 0);
        if (old_ == (unsigned)G - 1u) {
            int w_ = -1;
            if (lane < 16) w_ = XB_XCNT(lane); else if (lane < 32) w_ = XB_XSUB(lane - 16); else if (lane < 48) w_ = XB_XGEN(lane - 32);
            else if (lane == 48) w_ = XB_TMO; else if (lane == 49) w_ = XB_TOP; else if (lane == 50) w_ = XB_TOPGEN; else if (lane == 51) w_ = CTL_EXIT;
            if (w_ >= 0) __hip_atomic_store((unsigned*)g_ctl + w_, 0u, __ATOMIC_RELAXED, __HIP_MEMORY_SCOPE_AGENT); } }
#undef IN
#undef SEAM
}

extern "C" void kernel_launch(void* const* d_in, const int* in_sizes, int n_in, void* d_out, int out_size, void* d_ws, size_t ws_size, hipStream_t stream) {
    static int grid = 0;
    if (grid == 0) {
        if (n_in != 24 || out_size != M * DM || ws_size < WS_END) { fprintf(stderr, "kernel_launch: unexpected shapes (n_in %d out %d ws %zu)\n", n_in, out_size, ws_size); grid = -1; return; }
        int dev = 0, cus = 0, per_cu = 0;
        hipGetDevice(&dev); hipDeviceGetAttribute(&cus, hipDeviceAttributeMultiprocessorCount, dev);
        if (hipFuncSetAttribute((const void*)mk_fwd, hipFuncAttributeMaxDynamicSharedMemorySize, LDS_BYTES) != hipSuccess) { fprintf(stderr, "kernel_launch: hipFuncSetAttribute failed\n"); grid = -1; return; }
        if (hipOccupancyMaxActiveBlocksPerMultiprocessor(&per_cu, (const void*)mk_fwd, 512, LDS_BYTES) != hipSuccess || per_cu < 1) { fprintf(stderr, "kernel_launch: occupancy query says %d blocks per CU\n", per_cu); per_cu = 1; }
        (void)hipGetLastError();
        grid = cus;
    }
    if (grid < 0) return;
    Params a{};
    for (int i = 0; i < 24; ++i) a.in[i] = (const float*)d_in[i];
    a.out = (float*)d_out; a.ws = (unsigned char*)d_ws;
#if MK_MULTI
    for (int ph = 0; ph < NPH; ++ph) { a.lo = ph; a.hi = ph + 1; hipLaunchKernelGGL(mk_fwd, dim3(grid), dim3(512), LDS_BYTES, stream, a); }
#else
    a.lo = 0; a.hi = NPH;
    void* args[] = {&a};
    hipError_t e = hipLaunchCooperativeKernel((const void*)mk_fwd, dim3(grid), dim3(512), args, LDS_BYTES, stream);
    if (e != hipSuccess) fprintf(stderr, "kernel_launch: cooperative launch failed: %s (grid %d)\n", hipGetErrorString(e), grid);
#endif
}
```

```cpp
#include <hip/hip_runtime.h>
#include <hip/hip_cooperative_groups.h>
#include <cstdio>
#include <cstdint>
namespace cg = cooperative_groups;
namespace pg8 {
#define PG8_LAS __attribute__((address_space(3)))
typedef unsigned short bf16_t;
typedef short bf16x8 __attribute__((ext_vector_type(8)));
typedef float f32x4 __attribute__((ext_vector_type(4)));
typedef unsigned u32x4 __attribute__((ext_vector_type(4)));
constexpr int BM = 256, BK = 64, HALF = 128, HTB = HALF * BK * 2  , STAGE_BYTES = 8 * HTB, NXCD = 8, WGM = 8;

__host__ __device__ __forceinline__ int lds_byte(int r, int c) { const int st = (r >> 4) * 2 + (c >> 5), rr = r & 15, cc = c & 31, ob = rr * 64 + cc * 2; return st * 1024 + (ob ^ (((ob >> 9) & 1) << 5)); }
__host__ __device__ __forceinline__ void stage_rc(int b, int& R, int& C) { const int st = b / 1024, sb = b % 1024, swz = sb ^ (((sb >> 9) & 1) << 5); R = (st >> 1) * 16 + swz / 64; C = (st & 1) * 32 + (swz % 64) / 2; }
__host__ __device__ __forceinline__ int perm32(int rho) { const int n = rho >> 4, i = rho & 15; return 8 * (i >> 2) + 4 * n + (i & 3); }

struct Unit { int pm, pn, rep; };
struct Gemm { const bf16_t* A; const bf16_t* Bt; int M, N, K; };

struct StaticOrder {
    int nM, nN, nwg, G, c, wgm;
    __host__ __device__ void init(int M, int N, int G_, int c_) { nM = M / BM; nN = N / BM; nwg = nM * nN; G = G_; c = c_; wgm = WGM; }
    __host__ __device__ bool next(int i, Unit& u) const {
        const long L = (long)i * G + c; if (L >= nwg) return false;
        int wgid = (int)L; { const int q = nwg / NXCD, r = nwg % NXCD, xcd = wgid % NXCD, off = wgid / NXCD; wgid = (xcd < r ? xcd * (q + 1) : r * (q + 1) + (xcd - r) * q) + off; }
        const int nig = wgm * nN, gid = wgid / nig, fm = gid * wgm, gsz = (nM - fm) < wgm ? (nM - fm) : wgm;
        u.pm = fm + ((wgid % nig) % gsz); u.pn = (wgid % nig) / gsz; return true;
    }
    __device__ __forceinline__ void a_ready(const Unit&) const {}
    __device__ __forceinline__ void done(const Unit&) const {}
};

__device__ __forceinline__ unsigned cvt_pk_bf16(float lo, float hi) { unsigned r; asm volatile("v_cvt_pk_bf16_f32 %0, %1, %2" : "=v"(r) : "v"(lo), "v"(hi)); return r; }
typedef float f32x2 __attribute__((ext_vector_type(2)));
__device__ __forceinline__ f32x2 gelu_pk(f32x2 v) {
    const f32x2 av = __builtin_elementwise_abs(v), d = av * 0.2316418882f + 1.0f;
    f32x2 t; t.x = __builtin_amdgcn_rcpf(d.x); t.y = __builtin_amdgcn_rcpf(d.y);
    f32x2 q = t * 0.5307027145f + (-0.7265760135f); q = q * t + 0.7107068705f; q = q * t + (-0.142248368f); q = q * t + 0.127414796f; q = q * t;
    const f32x2 s = (v * v) * (-0.72134752044f);
    f32x2 e; e.x = __builtin_amdgcn_exp2f(s.x); e.y = __builtin_amdgcn_exp2f(s.y);
    const f32x2 m = v * (q * e), r = v - m;
    f32x2 o; o.x = v.x < 0.f ? m.x : r.x; o.y = v.y < 0.f ? m.y : r.y; return o;
}

template <int ACT  > struct EpiBf16 {
    static constexpr bool PERM = true, AFTER_DRAIN = false; static_assert(ACT == 0 || ACT == 1, "EpiBf16: ACT is 0 (none) or 1 (gelu_pk)");
    bf16_t* O; int ldc; const float* bias; int split_cols; size_t split_stride; float scale0;
    __device__ __forceinline__ void operator()(const f32x4 (&acc)[2][2][4][2], const Unit& u, int wr, int wc, int fr, int fq) const {
        const int row0 = u.pm * BM + wr * 64 + fr; int colt = u.pn * BM; bf16_t* base = O;
        float sc = 1.f; if (split_cols) { const int t = colt / split_cols; base += (size_t)t * split_stride; colt -= t * split_cols; if (t == 0) sc = scale0; }
        const int col0 = colt + wc * 32 + 8 * fq, bcol0 = u.pn * BM + wc * 32 + 8 * fq;
        f32x4 bv[2][2];
#pragma unroll
        for (int bj = 0; bj < 2; ++bj)
#pragma unroll
            for (int n = 0; n < 2; ++n) bv[bj][n] = bias ? *(const f32x4*)(bias + bcol0 + bj * HALF + 4 * n) : (f32x4){0.f, 0.f, 0.f, 0.f};
#pragma unroll
        for (int ai = 0; ai < 2; ++ai)
#pragma unroll
            for (int m = 0; m < 4; ++m) { bf16_t* rowp = base + (size_t)(row0 + ai * HALF + m * 16) * ldc + col0;
#pragma unroll
                for (int bj = 0; bj < 2; ++bj) { f32x4 v0 = acc[ai][bj][m][0] + bv[bj][0], v1 = acc[ai][bj][m][1] + bv[bj][1];
                    if (ACT == 1) { f32x2 a = gelu_pk((f32x2){v0[0], v0[1]}), b = gelu_pk((f32x2){v0[2], v0[3]}), c = gelu_pk((f32x2){v1[0], v1[1]}), d = gelu_pk((f32x2){v1[2], v1[3]});
                        v0 = (f32x4){a.x, a.y, b.x, b.y}; v1 = (f32x4){c.x, c.y, d.x, d.y}; }
                    v0 = v0 * sc; v1 = v1 * sc; u32x4 w; w.x = cvt_pk_bf16(v0[0], v0[1]); w.y = cvt_pk_bf16(v0[2], v0[3]); w.z = cvt_pk_bf16(v1[0], v1[1]); w.w = cvt_pk_bf16(v1[2], v1[3]);
                    *(u32x4*)(rowp + bj * HALF) = w; } }
    }
};

template <class Epi, class Sched, bool ALIGN_EPI = false, bool SP2 = false>
__device__ __forceinline__ void gemm_phase(PG8_LAS unsigned char* lds, const Gemm g, const Sched& S, const Epi& E) {
    const int tid = threadIdx.x, wid = __builtin_amdgcn_readfirstlane(tid >> 6), lane = tid & 63, wr = wid >> 2, wc = wid & 3, fr = lane & 15, fq = lane >> 4;
    const int K = g.K, nt = K / BK;
    unsigned voffA[2], voffB[2];
#pragma unroll
    for (int i = 0; i < 2; ++i) { int R, C; stage_rc(tid * 16 + i * 8192, R, C); const int Rb = Epi::PERM ? ((R & ~31) + perm32(R & 31)) : R;
        voffA[i] = (unsigned)(R * K + C) * 2u; voffB[i] = (unsigned)(Rb * K + C) * 2u; }
    const size_t kstep = (size_t)(BK * 2);
    const size_t hstep = (size_t)HALF * K * 2;
    const size_t tstep = 2 * hstep;
    const unsigned ldsw = (unsigned)wid * 1024u;
    const int aoff = lds_byte(wr * 64 + fr, fq * 8), boff = lds_byte(wc * 32 + fr, fq * 8);
#define PG8_SA(b, h) (((b) * 2 + (h)) * HTB)
#define PG8_SB(b, h) ((4 + (b) * 2 + (h)) * HTB)
#define PG8_STAGE(bufoff, gbase, voff) do { _Pragma("unroll") for (int _i = 0; _i < 2; ++_i) \
        __builtin_amdgcn_global_load_lds((const unsigned*)((const char*)(gbase) + (voff)[_i]), (PG8_LAS unsigned*)(lds + (bufoff) + ldsw + _i * 8192), 16, 0, 0); } while (0)
#define PG8_LDA(dst, b, h) do { _Pragma("unroll") for (int m = 0; m < 4; ++m) _Pragma("unroll") for (int k = 0; k < 2; ++k) dst[m][k] = *(const PG8_LAS bf16x8*)(lds + PG8_SA(b, h) + aoff + m * 2048 + k * 1024); } while (0)
#define PG8_LDB(dst, b, h) do { _Pragma("unroll") for (int n = 0; n < 2; ++n) _Pragma("unroll") for (int k = 0; k < 2; ++k) dst[n][k] = *(const PG8_LAS bf16x8*)(lds + PG8_SB(b, h) + boff + n * 2048 + k * 1024); } while (0)
#define PG8_MMA(ai, bj, At, Bt) do { __builtin_amdgcn_s_setprio(1); _Pragma("unroll") for (int m = 0; m < 4; ++m) _Pragma("unroll") for (int n = 0; n < 2; ++n) _Pragma("unroll") for (int k = 0; k < 2; ++k) \
        acc[ai][bj][m][n] = __builtin_amdgcn_mfma_f32_16x16x32_bf16(Bt[n][k], At[m][k], acc[ai][bj][m][n], 0, 0, 0); __builtin_amdgcn_s_setprio(0); } while (0)
#define PG8_WAIT_V(n) asm volatile("s_waitcnt vmcnt(" #n ")" ::: "memory")
#define PG8_WAIT_L(n) asm volatile("s_waitcnt lgkmcnt(" #n ")" ::: "memory")
#define PG8_BAR __builtin_amdgcn_s_barrier()
#define PG8_SCHED __builtin_amdgcn_sched_barrier(0)
    Unit cur, nxt; int ui = 0;
    if (!S.next(0, cur)) return;
    f32x4 acc[2][2][4][2];
#pragma unroll
    for (int a = 0; a < 2; ++a)
#pragma unroll
        for (int b = 0; b < 2; ++b)
#pragma unroll
            for (int m = 0; m < 4; ++m)
#pragma unroll
                for (int n = 0; n < 2; ++n) acc[a][b][m][n] = (f32x4){0.f, 0.f, 0.f, 0.f};
    bf16x8 At[4][2], B0[2][2], B1[2][2];
    const char* cA = (const char*)g.A + (size_t)cur.pm * tstep; const char* cB = (const char*)g.Bt + (size_t)cur.pn * tstep;
    S.a_ready(cur);
    if constexpr (SP2) {
        PG8_STAGE(PG8_SB(0, 0), cB, voffB); PG8_STAGE(PG8_SB(0, 1), cB + hstep, voffB); PG8_STAGE(PG8_SA(0, 0), cA, voffA); PG8_STAGE(PG8_SA(0, 1), cA + hstep, voffA);
        if (wr == 1) PG8_BAR;
        PG8_WAIT_V(2); PG8_BAR;
        PG8_STAGE(PG8_SB(1, 0), cB + kstep, voffB); PG8_STAGE(PG8_SA(1, 0), cA + kstep, voffA); PG8_STAGE(PG8_SB(1, 1), cB + hstep + kstep, voffB);
        PG8_WAIT_V(6); PG8_BAR;
    } else {
        PG8_STAGE(PG8_SB(0, 0), cB, voffB); PG8_STAGE(PG8_SA(0, 0), cA, voffA); PG8_STAGE(PG8_SB(0, 1), cB + hstep, voffB); PG8_STAGE(PG8_SA(0, 1), cA + hstep, voffA);
        if (wr == 1) PG8_BAR;
        PG8_WAIT_V(4); PG8_BAR;
        PG8_STAGE(PG8_SB(1, 0), cB + kstep, voffB); PG8_STAGE(PG8_SA(1, 0), cA + kstep, voffA); PG8_STAGE(PG8_SB(1, 1), cB + hstep + kstep, voffB);
        PG8_WAIT_V(6); PG8_BAR;
    }
    for (;;) {
        const bool has_next = S.next(ui + 1, nxt);
        const char* nA = has_next ? (const char*)g.A + (size_t)nxt.pm * tstep : cA; const char* nB = has_next ? (const char*)g.Bt + (size_t)nxt.pn * tstep : cB;
        for (int t = 0; t < nt; t += 2) {
            const bool last = (t == nt - 2);
            const char* a1 = cA + (size_t)(t + 1) * kstep;
            const char* a2 = last ? nA : cA + (size_t)(t + 2) * kstep; const char* b2 = last ? nB : cB + (size_t)(t + 2) * kstep;
            const char* a3 = a2 + kstep; const char* b3 = b2 + kstep;
            if (last && has_next) S.a_ready(nxt);
            if constexpr (SP2) {
            PG8_LDB(B0, 0, 0); PG8_LDB(B1, 0, 1); PG8_SCHED; PG8_LDA(At, 0, 0); PG8_STAGE(PG8_SA(1, 1), a1 + hstep, voffA);
            PG8_WAIT_V(8); PG8_WAIT_L(0); PG8_BAR; PG8_MMA(0, 0, At, B0); PG8_MMA(0, 1, At, B1); PG8_BAR; PG8_SCHED;
            PG8_LDA(At, 0, 1); PG8_STAGE(PG8_SB(0, 0), b2, voffB); PG8_STAGE(PG8_SB(0, 1), b2 + hstep, voffB); PG8_STAGE(PG8_SA(0, 0), a2, voffA);
            PG8_WAIT_V(8); PG8_WAIT_L(0); PG8_BAR; PG8_MMA(1, 0, At, B0); PG8_MMA(1, 1, At, B1); PG8_BAR; PG8_SCHED;
            PG8_LDB(B0, 1, 0); PG8_LDB(B1, 1, 1); PG8_SCHED; PG8_LDA(At, 1, 0); PG8_STAGE(PG8_SA(0, 1), a2 + hstep, voffA);
            PG8_WAIT_V(8); PG8_WAIT_L(0); PG8_BAR; PG8_MMA(0, 0, At, B0); PG8_MMA(0, 1, At, B1); PG8_BAR; PG8_SCHED;
            PG8_LDA(At, 1, 1); PG8_STAGE(PG8_SB(1, 0), b3, voffB); PG8_STAGE(PG8_SB(1, 1), b3 + hstep, voffB); PG8_STAGE(PG8_SA(1, 0), a3, voffA);
            PG8_WAIT_V(8); PG8_WAIT_L(0); PG8_BAR; PG8_MMA(1, 0, At, B0); PG8_MMA(1, 1, At, B1); PG8_BAR; PG8_SCHED;
            } else {
            PG8_LDB(B0, 0, 0); PG8_SCHED; PG8_LDA(At, 0, 0); PG8_STAGE(PG8_SA(1, 1), a1 + hstep, voffA);
            PG8_WAIT_L(8); PG8_BAR; PG8_WAIT_L(0); PG8_MMA(0, 0, At, B0); PG8_BAR; PG8_SCHED;
            PG8_LDB(B1, 0, 1); PG8_STAGE(PG8_SB(0, 0), b2, voffB);
            PG8_BAR; PG8_WAIT_L(0); PG8_MMA(0, 1, At, B1); PG8_BAR;
            PG8_LDA(At, 0, 1); PG8_STAGE(PG8_SA(0, 0), a2, voffA);
            PG8_BAR; PG8_WAIT_L(0); PG8_MMA(1, 0, At, B0); PG8_BAR; PG8_SCHED;
            PG8_STAGE(PG8_SB(0, 1), b2 + hstep, voffB);
            PG8_WAIT_V(6); PG8_BAR; PG8_MMA(1, 1, At, B1); PG8_BAR;
            PG8_LDB(B0, 1, 0); PG8_SCHED; PG8_LDA(At, 1, 0); PG8_STAGE(PG8_SA(0, 1), a2 + hstep, voffA);
            PG8_WAIT_L(8); PG8_BAR; PG8_WAIT_L(0); PG8_MMA(0, 0, At, B0); PG8_BAR; PG8_SCHED;
            PG8_LDB(B1, 1, 1); PG8_STAGE(PG8_SB(1, 0), b3, voffB);
            PG8_BAR; PG8_WAIT_L(0); PG8_MMA(0, 1, At, B1); PG8_BAR;
            PG8_LDA(At, 1, 1); PG8_STAGE(PG8_SA(1, 0), a3, voffA);
            PG8_BAR; PG8_WAIT_L(0); PG8_MMA(1, 0, At, B0); PG8_BAR; PG8_SCHED;
            PG8_STAGE(PG8_SB(1, 1), b3 + hstep, voffB);
            PG8_WAIT_V(6); PG8_BAR; PG8_MMA(1, 1, At, B1); PG8_BAR;
            }
        }
        if constexpr (ALIGN_EPI) { if (wr == 0) PG8_BAR; }
        if constexpr (!Epi::AFTER_DRAIN) { E(acc, cur, wr, wc, fr, fq); S.done(cur); }
        if (!has_next) break;
#pragma unroll
        for (int a = 0; a < 2; ++a)
#pragma unroll
            for (int b = 0; b < 2; ++b)
#pragma unroll
                for (int m = 0; m < 4; ++m)
#pragma unroll
                    for (int n = 0; n < 2; ++n) acc[a][b][m][n] = (f32x4){0.f, 0.f, 0.f, 0.f};
        cur = nxt; cA = nA; cB = nB; ++ui;
        if constexpr (ALIGN_EPI) { if (wr == 1) PG8_BAR; }
    }
    PG8_WAIT_V(0);
    if constexpr (!ALIGN_EPI) { if (wr == 0) PG8_BAR; }
    PG8_BAR;
    if constexpr (Epi::AFTER_DRAIN) { E.fused(acc, cur, wr, wc, fr, fq, lds, wid, lane); S.done(cur); }
#undef PG8_SA
#undef PG8_SB
#undef PG8_STAGE
#undef PG8_LDA
#undef PG8_LDB
#undef PG8_MMA
#undef PG8_WAIT_V
#undef PG8_WAIT_L
#undef PG8_BAR
#undef PG8_SCHED
}
}

#ifndef MK_MULTI
#define MK_MULTI 0
#endif
#ifndef MK_REPEAT_MASK
#define MK_REPEAT_MASK 0
#endif
#define REP(k) for (int rep_ = 0; rep_ <= ((MK_REPEAT_MASK >> (k)) & 1); ++rep_)
#define LAS __attribute__((address_space(3)))
typedef unsigned short bf16;
typedef float f32x4 __attribute__((ext_vector_type(4)));
typedef float f32x2 __attribute__((ext_vector_type(2)));
typedef unsigned u32x4 __attribute__((ext_vector_type(4)));
typedef unsigned u32x2 __attribute__((ext_vector_type(2)));
typedef short bf16x8 __attribute__((ext_vector_type(8)));

constexpr int BATCH = 2, SEQ = 8192, DM = 2048, M = BATCH * SEQ;
constexpr int AW = 1024, SWID = 512, DFF = 5632, INC = 5888;
constexpr float EPS = 1e-6f;
constexpr int NPH = 11;
constexpr size_t MiB = 1u << 20;
constexpr size_t WS_RSTD1 = 0, WS_SS2 = 64 * 1024, WS_SS3 = 128 * 1024, WS_LAM = 192 * 1024, WS_LAMT = 208 * 1024, WS_BBAR = 256 * 1024, WS_SLOC = 1 * MiB;
constexpr size_t WS_WIN = 16 * MiB, WS_WGLU = 39 * MiB, WS_WBA = 40 * MiB, WS_WBS = 44 * MiB, WS_WOUT = 46 * MiB, WS_WUP = 54 * MiB, WS_WDN = 98 * MiB;
constexpr size_t WS_XB = 120 * MiB;
constexpr size_t WS_HPREV = 120 * MiB, WS_HG = 132 * MiB, WS_HV = 144 * MiB;
constexpr size_t WS_Q = 184 * MiB, WS_ATT = 216 * MiB, WS_K = 248 * MiB, WS_VT = 252 * MiB, WS_U = 256 * MiB, WS_G = 288 * MiB;
constexpr size_t WS_YG = 416 * MiB, WS_SSM = 432 * MiB, WS_X1B = 448 * MiB, WS_END = 512 * MiB;
constexpr size_t WS_ACT = 184 * MiB;
__device__ unsigned g_ctl[4096];
constexpr int CTL_EXIT = 3520;
constexpr size_t WS_BAR = 768 * 1024;
constexpr int BAR_ZERO_BYTES = 16384;
constexpr int LDS_BYTES = 147456, MISC_OFF = LDS_BYTES - 16;

struct Params { const float* in[24]; float* out; unsigned char* ws; int lo, hi; };

__device__ __forceinline__ float wave_sum(float v) {
#pragma unroll
    for (int o = 1; o < 64; o <<= 1) v += __shfl_xor(v, o);
    return v;
}
typedef __bf16 bf16x2_t __attribute__((ext_vector_type(2)));
__device__ __forceinline__ unsigned pk2(float lo, float hi) { const bf16x2_t r = __builtin_convertvector((f32x2){lo, hi}, bf16x2_t); return __builtin_bit_cast(unsigned, r); }
__device__ __forceinline__ u32x4 pack8(f32x4 a, f32x4 b) { u32x4 w; w.x = pk2(a[0], a[1]); w.y = pk2(a[2], a[3]); w.z = pk2(b[0], b[1]); w.w = pk2(b[2], b[3]); return w; }
__device__ __forceinline__ f32x4 unpk_lo(u32x4 w) { return (f32x4){__uint_as_float(w.x << 16), __uint_as_float(w.x & 0xffff0000u), __uint_as_float(w.y << 16), __uint_as_float(w.y & 0xffff0000u)}; }
__device__ __forceinline__ f32x4 unpk_hi(u32x4 w) { return (f32x4){__uint_as_float(w.z << 16), __uint_as_float(w.z & 0xffff0000u), __uint_as_float(w.w << 16), __uint_as_float(w.w & 0xffff0000u)}; }
__device__ __forceinline__ float sigm(float x) { return __builtin_amdgcn_rcpf(1.f + __builtin_amdgcn_exp2f(-1.4426950408889634f * x)); }
__device__ __forceinline__ float sigmf(float x) { return __builtin_amdgcn_rcpf(1.f + __builtin_amdgcn_exp2f(-1.4426950408889634f * x)); }
__device__ __forceinline__ f32x4 sigm4f(f32x4 v) { return (f32x4){sigmf(v[0]), sigmf(v[1]), sigmf(v[2]), sigmf(v[3])}; }
__device__ __forceinline__ f32x4 sigm4(f32x4 v) { return (f32x4){sigm(v[0]), sigm(v[1]), sigm(v[2]), sigm(v[3])}; }
__device__ __forceinline__ float gelu_exact(float x) { return 0.5f * x * (1.f + erff(x * 0.70710678118654752f)); }
__device__ __forceinline__ f32x4 gelu4(f32x4 v) { pg8::f32x2 a = pg8::gelu_pk((pg8::f32x2){v[0], v[1]}), b = pg8::gelu_pk((pg8::f32x2){v[2], v[3]}); return (f32x4){a.x, a.y, b.x, b.y}; }
#define LDS_WAIT() asm volatile("s_waitcnt lgkmcnt(0)" ::: "memory")

#define XB_TMO      128
#define XB_XCNT(j)  (256  + 64 * (j))
#define XB_XSUB(j)  (1280 + 64 * (j))
#define XB_XGEN(j)  (2304 + 64 * (j))
#define XB_TOP      3328
#define XB_TOPGEN   3392
#define XCD_BAR_WORDS 3456
#define XB_SPIN_CAP (1u << 18)

__device__ __forceinline__ unsigned xb_ld(unsigned* p)              { return __hip_atomic_load(p, __ATOMIC_RELAXED, __HIP_MEMORY_SCOPE_AGENT); }
__device__ __forceinline__ unsigned xb_add(unsigned* p, unsigned v) { return __hip_atomic_fetch_add(p, v, __ATOMIC_RELAXED, __HIP_MEMORY_SCOPE_AGENT); }
__device__ __forceinline__ unsigned xb_xcc_id() { return (unsigned)__builtin_amdgcn_s_getreg((3 << 11) | 20) & 0xFu; }
#define XB_SPIN(cond, bar) do { unsigned _sp = 0; while (cond) { __builtin_amdgcn_s_sleep(1); \
    if ((++_sp & 255u) == 0u) { if (xb_ld(&(bar)[XB_TMO])) break; if (_sp > XB_SPIN_CAP) { atomicAdd(&(bar)[XB_TMO], 1u); break; } } } } while (0)

struct XcdBarrier {
    unsigned* bar; unsigned x;
    volatile LAS unsigned* st;
};

__device__ __forceinline__ XcdBarrier xcd_barrier_post(unsigned* bar, volatile LAS unsigned* st) {
    XcdBarrier b; b.bar = bar; b.x = xb_xcc_id(); b.st = st;
    if (threadIdx.x == 0) (void)xb_add(&bar[XB_XCNT(b.x)], 1u);
    return b;
}
__device__ __forceinline__ void xcd_barrier_complete(unsigned* bar, unsigned x, unsigned& nloc, unsigned& nx) {
    const unsigned G = gridDim.x * gridDim.y * gridDim.z;
    unsigned sum, cnt, mine, sp = 0u;
    for (;;) {
        sum = 0u; cnt = 0u; mine = 0u;
#pragma unroll
        for (unsigned j = 0; j < 16; ++j) { const unsigned c = xb_ld(&bar[XB_XCNT(j)]); sum += c; cnt += (c > 0u) ? 1u : 0u; mine = (j == x) ? c : mine; }
        if (sum == G) break;
        __builtin_amdgcn_s_sleep(1);
        if ((++sp & 255u) == 0u) { if (xb_ld(&bar[XB_TMO])) break; if (sp > XB_SPIN_CAP) { atomicAdd(&bar[XB_TMO], 1u); break; } }
    }
    nloc = mine > 0u ? mine : 1u; nx = cnt > 0u ? cnt : 1u;
}

__device__ __forceinline__ void xcd_barrier(const XcdBarrier& b) {
    asm volatile("s_waitcnt vmcnt(0)" ::: "memory");
    __syncthreads();
    if (threadIdx.x == 0) {
        unsigned* bar = b.bar;
        __builtin_amdgcn_s_waitcnt(0);
        unsigned nloc = b.st[0], nx = b.st[1];
        if (nloc == 0u) { xcd_barrier_complete(bar, b.x, nloc, nx); b.st[0] = nloc; b.st[1] = nx; }
        const unsigned old = xb_add(&bar[XB_XSUB(b.x)], 1u);
        const unsigned gen = old / nloc;
        if (old + 1u == (gen + 1u) * nloc) {
            __builtin_amdgcn_fence(__ATOMIC_RELEASE, "agent");
            asm volatile("s_waitcnt vmcnt(0)" ::: "memory");
            const unsigned og = xb_add(&bar[XB_TOP], 1u);
            const unsigned tg = og / nx;
            if (og + 1u == (tg + 1u) * nx) xb_add(&bar[XB_TOPGEN], 1u);
            else XB_SPIN(xb_ld(&bar[XB_TOPGEN]) == tg, bar);
            __builtin_amdgcn_fence(__ATOMIC_ACQUIRE, "agent");
            xb_add(&bar[XB_XGEN(b.x)], 1u);
            asm volatile("s_waitcnt vmcnt(0)" ::: "memory");
        } else {
            XB_SPIN(xb_ld(&bar[XB_XGEN(b.x)]) == gen, bar);
            __builtin_amdgcn_fence(__ATOMIC_ACQUIRE, "agent");
            asm volatile("s_waitcnt vmcnt(0)" ::: "memory");
        }
    }
    __syncthreads();
}

__device__ __forceinline__ void tr_tile(const float* __restrict__ W, int K, int N, bf16* __restrict__ WT, int k0, int n0, int drow0, const float* __restrict__ gs, LAS float* scr, int lane) {
    const int q = lane & 15, rr = lane >> 4;
    f32x4 v[16];
#pragma unroll
    for (int i = 0; i < 16; ++i) v[i] = __builtin_nontemporal_load((const f32x4*)(W + (size_t)(k0 + 4 * i + rr) * N + n0 + 4 * q));
#pragma unroll
    for (int i = 0; i < 16; ++i) { const int kk = 4 * i + rr; const float s = gs ? gs[k0 + kk] : 1.f; LAS float* d = scr + kk * 65 + 4 * q;
        d[0] = v[i][0] * s; d[1] = v[i][1] * s; d[2] = v[i][2] * s; d[3] = v[i][3] * s; }
    LDS_WAIT();
    const int c = lane & 7, nn = lane >> 3;
#pragma unroll
    for (int j = 0; j < 8; ++j) { const int n = 8 * j + nn; const LAS float* s = scr + (8 * c) * 65 + n;
        u32x4 o; o.x = pk2(s[0], s[65]); o.y = pk2(s[2 * 65], s[3 * 65]); o.z = pk2(s[4 * 65], s[5 * 65]); o.w = pk2(s[6 * 65], s[7 * 65]);
        *(u32x4*)(WT + (size_t)(drow0 + n) * K + k0 + 8 * c) = o; }
    LDS_WAIT();
}
__device__ __forceinline__ void tr_item(const float* __restrict__ W, int K, int N, bf16* __restrict__ WT, int mode, const float* __restrict__ gs, LAS float* scr, int item, int lane) {
    const int nblk = N / 64, kb = item / nblk, nb = item % nblk, k0 = 64 * kb, n0 = 64 * nb;
    int drow0 = n0;
    if (mode) { const int half = N >> 1, bj = n0 >= half ? 1 : 0, cc = n0 - bj * half; drow0 = 256 * (cc >> 7) + 128 * bj + (cc & 127); }
    tr_tile(W, K, N, WT, k0, n0, drow0, gs, scr, lane);
}

__device__ __forceinline__ void p0_prologue(const Params& p, LAS unsigned char* lds, int tid, int wave, int lane, int G) {
    unsigned char* ws = p.ws;
    LAS float* scr = (LAS float*)(lds + wave * 16640);
    const int gw = blockIdx.x * 8 + wave, NGW = G * 8;
    constexpr int I0 = (2048 / 64) * (INC / 64), I1 = (512 / 64) * (1024 / 64), I2 = (1024 / 64) * (2048 / 64), I3 = (512 / 64) * (2048 / 64), I4 = (2048 / 64) * (2048 / 64),
                  I5 = (2048 / 64) * (2 * DFF / 64), I6 = (DFF / 64) * (2048 / 64);
    for (int it = gw; it < I0 + I4 + I2 + I3 + I1; it += NGW) {
        int r = it;
        if (r < I0) { tr_item(p.in[2], 2048, INC, (bf16*)(ws + WS_WIN), 0, p.in[1], scr, r, lane); continue; } r -= I0;
        if (r < I4) { tr_item(p.in[17], 2048, 2048, (bf16*)(ws + WS_WOUT), 0, nullptr, scr, r, lane); continue; } r -= I4;
        if (r < I2) { tr_item(p.in[15], 1024, 2048, (bf16*)(ws + WS_WBA), 0, nullptr, scr, r, lane); continue; } r -= I2;
        if (r < I3) { tr_item(p.in[16], 512, 2048, (bf16*)(ws + WS_WBS), 0, nullptr, scr, r, lane); continue; } r -= I3;
        tr_item(p.in[13], 512, 1024, (bf16*)(ws + WS_WGLU), 1, nullptr, scr, r, lane);
    }
    const float* x = p.in[0]; bf16* XB = (bf16*)(ws + WS_XB); float* rstd1 = (float*)(ws + WS_RSTD1);
    for (int m = gw; m < M; m += NGW) {
        const f32x4* xr = (const f32x4*)(x + (size_t)m * DM) + lane;
        f32x4 v[8]; float ss = 0.f;
#pragma unroll
        for (int j = 0; j < 8; ++j) { v[j] = __builtin_nontemporal_load(xr + 64 * j); ss += (v[j][0] * v[j][0] + v[j][1] * v[j][1]) + (v[j][2] * v[j][2] + v[j][3] * v[j][3]); }
        ss = wave_sum(ss);
        if (lane == 0) rstd1[m] = rsqrtf(ss * (1.f / DM) + EPS);
        u32x2* o = (u32x2*)(XB + (size_t)m * DM) + lane;
#pragma unroll
        for (int j = 0; j < 8; ++j) { u32x2 w; w.x = pk2(v[j][0], v[j][1]); w.y = pk2(v[j][2], v[j][3]); o[64 * j] = w; }
    }
    { float* z2 = (float*)(ws + WS_SS2); float* z3 = (float*)(ws + WS_SS3);
      for (int i = blockIdx.x * 512 + tid; i < M; i += G * 512) { z2[i] = 0.f; z3[i] = 0.f; } }
    { const int gt = blockIdx.x * 512 + tid;
      if (gt < 2048) {
        const int g = gt >> 6;
        const float dt = expf(p.in[7][g]); const float ar = p.in[5][gt], ai = p.in[6][gt];
        const float em1 = expm1f(ar * dt), mag = em1 + 1.f; const float th = ai * dt;
        const float sn = sinf(th), cs = cosf(th), sh = sinf(0.5f * th);
        const float lr = mag * cs, li = mag * sn;
        const float nr = em1 * cs - 2.f * sh * sh, ni = li;
        const float den = ar * ar + ai * ai;
        const float zr = (nr * ar + ni * ai) / den, zi = (ni * ar - nr * ai) / den;
        f32x2* Bb = (f32x2*)(ws + WS_BBAR) + (size_t)gt * 16;
#pragma unroll
        for (int h = 0; h < 16; ++h) { const float br = p.in[8][(size_t)gt * 16 + h], bi = p.in[9][(size_t)gt * 16 + h]; Bb[h] = (f32x2){zr * br - zi * bi, zr * bi + zi * br}; }
        ((f32x2*)(ws + WS_LAM))[gt] = (f32x2){lr, li};
        float pr = lr, pi = li;
#pragma unroll
        for (int s = 0; s < 8; ++s) { const float nr2 = pr * pr - pi * pi, ni2 = 2.f * pr * pi; pr = nr2; pi = ni2; }
        ((f32x2*)(ws + WS_LAMT))[gt] = (f32x2){pr, pi};
      } }
}

#define EPI_ROW(ai, m) (u.pm * 256 + (ai) * 128 + wr * 64 + (m) * 16 + fr)
#define EPI_COL(bj) (u.pn * 256 + (bj) * 128 + wc * 32 + 8 * fq)
typedef pg8::f32x4 ACC_T[2][2][4][2];
struct RepOrder : pg8::StaticOrder {
    int reps;
    __device__ __forceinline__ bool next(int i, pg8::Unit& u) const { const int n = (nwg - c + G - 1) / G; if (n <= 0 || i >= reps * n) return false; u.rep = i / n; return pg8::StaticOrder::next(i % n, u); }
};
#define REPS(k) (1 + ((MK_REPEAT_MASK >> (k)) & 1))

struct EpiIn {
    static constexpr bool PERM = true, AFTER_DRAIN = false;
    const float* rstd; const float* bias; bf16* Q; bf16* K; bf16* VT; float* U; bf16* G;
    __device__ __forceinline__ void operator()(const ACC_T& acc, const pg8::Unit& u, int wr, int wc, int fr, int fq) const {
        const int pn = u.pn;
        f32x4 bv[2][2];
#pragma unroll
        for (int bj = 0; bj < 2; ++bj) { bv[bj][0] = *(const f32x4*)(bias + EPI_COL(bj)); bv[bj][1] = *(const f32x4*)(bias + EPI_COL(bj) + 4); }
#pragma unroll
        for (int ai = 0; ai < 2; ++ai)
#pragma unroll
            for (int m = 0; m < 4; ++m) { const int row = EPI_ROW(ai, m); const float rs = rstd[row];
#pragma unroll
                for (int bj = 0; bj < 2; ++bj) { const int col = EPI_COL(bj);
                    f32x4 v0 = acc[ai][bj][m][0] * rs + bv[bj][0], v1 = acc[ai][bj][m][1] * rs + bv[bj][1];
                    if (pn < 4) { v0 = v0 * 0.125f; v1 = v1 * 0.125f; *(u32x4*)(Q + (size_t)row * AW + col) = pack8(v0, v1); }
                    else if (pn == 4) {
                        if (bj == 0) *(u32x4*)(K + (size_t)row * 128 + (col - 1024)) = pack8(v0, v1);
                        else { const int c = col - 1152, gg = c >> 6, d = c & 63, bb = row >> 13, t = row & (SEQ - 1);
                            bf16* pp = VT + (size_t)((bb * 2 + gg) * 64 + d) * SEQ + t; const u32x4 w = pack8(v0, v1);
                            pp[0] = (bf16)(w.x & 0xffff); pp[SEQ] = (bf16)(w.x >> 16); pp[2 * SEQ] = (bf16)(w.y & 0xffff); pp[3 * SEQ] = (bf16)(w.y >> 16);
                            pp[4 * SEQ] = (bf16)(w.z & 0xffff); pp[5 * SEQ] = (bf16)(w.z >> 16); pp[6 * SEQ] = (bf16)(w.w & 0xffff); pp[7 * SEQ] = (bf16)(w.w >> 16); }
                    }
                    else if (pn < 7) { float* pp = U + (size_t)row * SWID + (col - 1280); *(f32x4*)pp = v0; *(f32x4*)(pp + 4) = v1; }
                    else { __builtin_nontemporal_store(pack8(sigm4(v0), sigm4(v1)), (u32x4*)(G + (size_t)row * 4096 + (col - 1792))); }
                } }
    }
};
struct EpiGlu {
    static constexpr bool PERM = true, AFTER_DRAIN = false;
    const float* bias; bf16* O;
    __device__ __forceinline__ void operator()(const ACC_T& acc, const pg8::Unit& u, int wr, int wc, int fr, int fq) const {
        const int ch = u.pn * 128 + wc * 32 + 8 * fq;
        const f32x4 bv0 = *(const f32x4*)(bias + ch), bv1 = *(const f32x4*)(bias + ch + 4), bg0 = *(const f32x4*)(bias + 512 + ch), bg1 = *(const f32x4*)(bias + 512 + ch + 4);
#pragma unroll
        for (int ai = 0; ai < 2; ++ai)
#pragma unroll
            for (int m = 0; m < 4; ++m) { const int row = EPI_ROW(ai, m);
                const f32x4 o0 = (acc[ai][0][m][0] + bv0) * sigm4f(acc[ai][1][m][0] + bg0), o1 = (acc[ai][0][m][1] + bv1) * sigm4f(acc[ai][1][m][1] + bg1);
                *(u32x4*)(O + (size_t)row * SWID + ch) = pack8(o0, o1); }
    }
};
struct EpiBrA {
    static constexpr bool PERM = true, AFTER_DRAIN = false;
    const bf16* G; bf16* T;
    __device__ __forceinline__ void operator()(const ACC_T& acc, const pg8::Unit& u, int wr, int wc, int fr, int fq) const {
#pragma unroll
        for (int ai = 0; ai < 2; ++ai)
#pragma unroll
            for (int m = 0; m < 4; ++m) { const int row = EPI_ROW(ai, m);
#pragma unroll
                for (int bj = 0; bj < 2; ++bj) { const int col = EPI_COL(bj); const u32x4 gw = __builtin_nontemporal_load((const u32x4*)(G + (size_t)row * 4096 + col));
                    *(u32x4*)(T + (size_t)row * DM + col) = pack8(unpk_lo(gw) * acc[ai][bj][m][0], unpk_hi(gw) * acc[ai][bj][m][1]); } }
    }
};
struct EpiBrB {
    static constexpr bool PERM = true, AFTER_DRAIN = false;
    const bf16* G; const bf16* T; bf16* O;
    __device__ __forceinline__ void operator()(const ACC_T& acc, const pg8::Unit& u, int wr, int wc, int fr, int fq) const {
#pragma unroll
        for (int ai = 0; ai < 2; ++ai)
#pragma unroll
            for (int m = 0; m < 4; ++m) { const int row = EPI_ROW(ai, m);
#pragma unroll
                for (int bj = 0; bj < 2; ++bj) { const int col = EPI_COL(bj); const u32x4 gw = __builtin_nontemporal_load((const u32x4*)(G + (size_t)row * 4096 + 2048 + col));
                    const u32x4 tw = *(const u32x4*)(T + (size_t)row * DM + col);
                    const f32x4 o0 = unpk_lo(tw) + unpk_lo(gw) * acc[ai][bj][m][0], o1 = unpk_hi(tw) + unpk_hi(gw) * acc[ai][bj][m][1];
                    *(u32x4*)(O + (size_t)row * DM + col) = pack8(o0, o1); } }
    }
};
struct EpiX1 {
    static constexpr bool PERM = true, AFTER_DRAIN = false;
    const float* base; bf16* ob; float* ss;
    __device__ __forceinline__ void operator()(const ACC_T& acc, const pg8::Unit& u, int wr, int wc, int fr, int fq) const {
#pragma unroll
        for (int ai = 0; ai < 2; ++ai)
#pragma unroll
            for (int m = 0; m < 4; ++m) { const int row = EPI_ROW(ai, m); float sq = 0.f;
#pragma unroll
                for (int bj = 0; bj < 2; ++bj) { const int col = EPI_COL(bj); const size_t off = (size_t)row * DM + col;
                    const f32x4 o0 = __builtin_nontemporal_load((const f32x4*)(base + off)) + acc[ai][bj][m][0], o1 = __builtin_nontemporal_load((const f32x4*)(base + off + 4)) + acc[ai][bj][m][1];
                    *(u32x4*)(ob + off) = pack8(o0, o1);
                    sq += (o0[0] * o0[0] + o0[1] * o0[1]) + (o0[2] * o0[2] + o0[3] * o0[3]) + (o1[0] * o1[0] + o1[1] * o1[1]) + (o1[2] * o1[2] + o1[3] * o1[3]); }
                sq += __shfl_xor(sq, 16); sq += __shfl_xor(sq, 32);
                if (fq == 0) atomicAdd(ss + row, sq); }
    }
};
struct EpiX2 {
    static constexpr bool PERM = true, AFTER_DRAIN = false;
    const bf16* base; bf16* ob; float* ss;
    __device__ __forceinline__ void operator()(const ACC_T& acc, const pg8::Unit& u, int wr, int wc, int fr, int fq) const {
#pragma unroll
        for (int ai = 0; ai < 2; ++ai)
#pragma unroll
            for (int m = 0; m < 4; ++m) { const int row = EPI_ROW(ai, m); float sq = 0.f;
#pragma unroll
                for (int bj = 0; bj < 2; ++bj) { const int col = EPI_COL(bj); const size_t off = (size_t)row * DM + col;
                    const u32x4 bw = __builtin_nontemporal_load((const u32x4*)(base + off));
                    const f32x4 o0 = unpk_lo(bw) + acc[ai][bj][m][0], o1 = unpk_hi(bw) + acc[ai][bj][m][1];
                    *(u32x4*)(ob + off) = pack8(o0, o1);
                    sq += (o0[0] * o0[0] + o0[1] * o0[1]) + (o0[2] * o0[2] + o0[3] * o0[3]) + (o1[0] * o1[0] + o1[1] * o1[1]) + (o1[2] * o1[2] + o1[3] * o1[3]); }
                sq += __shfl_xor(sq, 16); sq += __shfl_xor(sq, 32);
                if (fq == 0) atomicAdd(ss + row, sq); }
    }
};
struct EpiUp {
    static constexpr bool PERM = true, AFTER_DRAIN = false;
    const float* ss2; const float* cw; const float* cb; bf16* ACT; float* HP; float* HG; float* HV;
    __device__ __forceinline__ void operator()(const ACC_T& acc, const pg8::Unit& u, int wr, int wc, int fr, int fq) const {
        const int ch0 = u.pn * 128 + wc * 32 + 8 * fq;
#pragma unroll
        for (int ai = 0; ai < 2; ++ai) {
            const int grp = u.pm * 4 + ai * 2 + wr, rowg0 = grp * 64;
            float rs[4];
#pragma unroll
            for (int m = 0; m < 4; ++m) rs[m] = rsqrtf(ss2[rowg0 + 16 * m + fr] * (1.f / DM) + EPS);
#pragma unroll
            for (int n = 0; n < 2; ++n) { const int ch = ch0 + 4 * n;
                const f32x4 w0 = *(const f32x4*)(cw + ch), w1 = *(const f32x4*)(cw + DFF + ch), w2 = *(const f32x4*)(cw + 2 * DFF + ch), bb = *(const f32x4*)(cb + ch);
                f32x4 p1 = (f32x4){0.f, 0.f, 0.f, 0.f}, p2 = p1;
#pragma unroll
                for (int m = 0; m < 4; ++m) {
                    const f32x4 g = acc[ai][1][m][n] * rs[m], v = acc[ai][0][m][n] * rs[m];
                    f32x4 c1, c2;
#pragma unroll
                    for (int e = 0; e < 4; ++e) { const int gi = __float_as_int(g[e]);
                        c1[e] = __int_as_float(__builtin_amdgcn_update_dpp(gi, gi, 0x121, 0xf, 0xf, false)); c2[e] = __int_as_float(__builtin_amdgcn_update_dpp(gi, gi, 0x122, 0xf, 0xf, false)); }
                    const f32x4 g1 = fr >= 1 ? c1 : p1, g2 = fr >= 2 ? c2 : p2;
                    const f32x4 cv = bb + w0 * g2 + w1 * g1 + w2 * g;
                    const f32x4 a = v * gelu4(cv);
                    const int row = rowg0 + 16 * m + fr;
                    if (m > 0 || fr >= 2) { u32x2 w; w.x = pk2(a[0], a[1]); w.y = pk2(a[2], a[3]); *(u32x2*)(ACT + (size_t)row * DFF + ch) = w; }
                    else { *(f32x4*)(HG + (size_t)(grp * 2 + fr) * DFF + ch) = g; *(f32x4*)(HV + (size_t)(grp * 2 + fr) * DFF + ch) = v; }
                    if (m == 3 && fr >= 14) *(f32x4*)(HP + (size_t)(grp * 2 + fr - 14) * DFF + ch) = g;
                    p1 = c1; p2 = c2;
                } }
        }
    }
};

__device__ __forceinline__ void attn_item(const Params& p, LAS unsigned char* lds, int item, int tid, int wave, int lane) {
    unsigned char* ws = p.ws;
    const bf16* Qg = (const bf16*)(ws + WS_Q); const bf16* Kg = (const bf16*)(ws + WS_K); const bf16* VTg = (const bf16*)(ws + WS_VT); bf16* Og = (bf16*)(ws + WS_ATT);
    const int g = item & 1, nb = (item >> 1) & 63, b = item >> 7;
    LAS bf16* Ks = (LAS bf16*)lds;
    LAS bf16* Vs = (LAS bf16*)(lds + 36864);
    const int t0 = nb * 128;
#pragma unroll
    for (int i = 0; i < 4; ++i) { const int idx = tid + 512 * i, r = idx >> 3, c8 = idx & 7;
        int tk = t0 - 128 + r; if (nb == 0 && r < 128) tk = r;
        const u32x4 v = *(const u32x4*)(Kg + (size_t)(b * SEQ + tk) * 128 + g * 64 + c8 * 8);
        *(LAS u32x4*)(Ks + r * 72 + c8 * 8) = v; }
#pragma unroll
    for (int i = 0; i < 4; ++i) { const int idx = tid + 512 * i, d = idx >> 5, c8 = idx & 31;
        int tk = t0 - 128 + c8 * 8; if (nb == 0 && c8 < 16) tk = c8 * 8;
        const u32x4 v = *(const u32x4*)(VTg + (size_t)((b * 2 + g) * 64 + d) * SEQ + tk);
        *(LAS u32x4*)(Vs + d * 264 + c8 * 8) = v; }
    __syncthreads();
    const int head = g * 8 + wave, qn = lane & 15, q4 = lane >> 4;
    const float slope = exp2f(-0.5f * (float)(head + 1)), sink = p.in[4][head];
    float ab[9][4];
#pragma unroll
    for (int j = 0; j < 9; ++j)
#pragma unroll
        for (int r = 0; r < 4; ++r) { const int dist = qn - 4 * q4 - r + 128 - 16 * j; ab[j][r] = (dist >= 0 && dist < 128) ? -slope * (float)dist : -1e30f; }
    bf16x8 nq0, nq1;
    { const bf16* qp = Qg + (size_t)(b * SEQ + t0 + qn) * AW + head * 64 + 8 * q4; nq0 = *(const bf16x8*)qp; nq1 = *(const bf16x8*)(qp + 32); }
    for (int qb = 0; qb < 8; ++qb) {
        const size_t qrow = (size_t)(b * SEQ + t0 + 16 * qb + qn);
        const bf16x8 bq0 = nq0, bq1 = nq1;
        if (qb < 7) { const bf16* qp = Qg + (qrow + 16) * AW + head * 64 + 8 * q4; nq0 = *(const bf16x8*)qp; nq1 = *(const bf16x8*)(qp + 32); }
        f32x4 S[10];
#pragma unroll
        for (int j = 0; j < 9; ++j) { const LAS bf16* kp = Ks + (16 * (qb + j) + qn) * 72 + 8 * q4;
            const bf16x8 a0 = *(const LAS bf16x8*)kp, a1 = *(const LAS bf16x8*)(kp + 32);
            f32x4 s = (f32x4){0.f, 0.f, 0.f, 0.f};
            s = __builtin_amdgcn_mfma_f32_16x16x32_bf16(a0, bq0, s, 0, 0, 0);
            s = __builtin_amdgcn_mfma_f32_16x16x32_bf16(a1, bq1, s, 0, 0, 0);
            S[j] = s; }
        float mx = sink;
        if (nb > 0) {
#pragma unroll
            for (int j = 0; j < 9; ++j)
#pragma unroll
                for (int r = 0; r < 4; ++r) { const float sc = S[j][r] + ab[j][r]; S[j][r] = sc; mx = fmaxf(mx, sc); }
        } else {
            const int qi = 16 * qb + qn;
#pragma unroll
            for (int j = 0; j < 9; ++j)
#pragma unroll
                for (int r = 0; r < 4; ++r) { const int s = 16 * (qb + j) + 4 * q4 + r, dist = qi + 128 - s;
                    const bool valid = (dist >= 0) && (dist < 128) && (s >= 128);
                    const float sc = valid ? (S[j][r] - slope * (float)dist) : -1e30f;
                    S[j][r] = sc; mx = fmaxf(mx, sc); }
        }
        mx = fmaxf(mx, __shfl_xor(mx, 16)); mx = fmaxf(mx, __shfl_xor(mx, 32));
        float sum = 0.f;
#pragma unroll
        for (int j = 0; j < 9; ++j)
#pragma unroll
            for (int r = 0; r < 4; ++r) { const float e = __expf(S[j][r] - mx); S[j][r] = e; sum += e; }
        sum += __shfl_xor(sum, 16); sum += __shfl_xor(sum, 32);
        const float inv = 1.f / (sum + __expf(sink - mx));
        S[9] = (f32x4){0.f, 0.f, 0.f, 0.f};
        f32x4 O[4];
#pragma unroll
        for (int db = 0; db < 4; ++db) O[db] = (f32x4){0.f, 0.f, 0.f, 0.f};
#pragma unroll
        for (int js = 0; js < 5; ++js) {
            const u32x4 pw = pack8(S[2 * js], S[2 * js + 1]);
            const bf16x8 pb = __builtin_bit_cast(bf16x8, pw);
            const int kb0 = qb + 2 * js; int kb1 = kb0 + 1; kb1 = kb1 > 15 ? 15 : kb1;
#pragma unroll
            for (int db = 0; db < 4; ++db) { const LAS bf16* vp = Vs + (16 * db + qn) * 264 + 4 * q4;
                const u32x2 lo = *(const LAS u32x2*)(vp + 16 * kb0), hi = *(const LAS u32x2*)(vp + 16 * kb1);
                const u32x4 aw = (u32x4){lo.x, lo.y, hi.x, hi.y};
                O[db] = __builtin_amdgcn_mfma_f32_16x16x32_bf16(__builtin_bit_cast(bf16x8, aw), pb, O[db], 0, 0, 0); }
        }
        bf16* op = Og + qrow * AW + head * 64 + 4 * q4;
#pragma unroll
        for (int db = 0; db < 4; ++db) { const f32x4 o = O[db] * inv; u32x2 w; w.x = pk2(o[0], o[1]); w.y = pk2(o[2], o[3]); *(u32x2*)(op + 16 * db) = w; }
    }
    __syncthreads();
}

constexpr int DT_UP = (2048 / 64) * (2 * DFF / 64), DT_DN = (DFF / 64) * (2048 / 64);
constexpr int NDEFH = 2 * (DT_UP + DT_DN), NP1 = 6144, NDEFH2 = NP1 + (NDEFH - NP1) / 2;
struct TJob { const float* W; bf16* WT; const float* gs; int K, N, k0, n0, drow0; };
__device__ __forceinline__ TJob def_job(const Params& p, int idx) {
    unsigned char* ws = p.ws; TJob j; int r = idx, mode = 0; j.gs = nullptr;
    if (r < DT_UP) { j.W = p.in[19]; j.WT = (bf16*)(ws + WS_WUP); j.gs = p.in[18]; j.K = 2048; j.N = 2 * DFF; mode = 1; }
    else { r -= DT_UP; j.W = p.in[22]; j.WT = (bf16*)(ws + WS_WDN); j.K = DFF; j.N = 2048; }
    const int nblk = j.N / 64, kb = r / nblk, nb = r - kb * nblk; j.k0 = 64 * kb; j.n0 = 64 * nb; j.drow0 = j.n0;
    if (mode) { const int half = j.N >> 1, bj = j.n0 >= half ? 1 : 0, cc = j.n0 - bj * half; j.drow0 = 256 * (cc >> 7) + 128 * bj + (cc & 127); }
    return j;
}
#define TILE_ISSUE_HALF(p_, idx_, h_, v_) do { const TJob j_ = def_job(p_, idx_); const int q_ = lane & 15, rr_ = lane >> 4; \
        _Pragma("unroll") for (int i_ = 0; i_ < 8; ++i_) v_[i_] = __builtin_nontemporal_load((const f32x4*)(j_.W + (size_t)(j_.k0 + 32 * (h_) + 4 * i_ + rr_) * j_.N + j_.n0 + 4 * q_)); } while (0)
__device__ __forceinline__ void tile_finish_half(const Params& p, int idx, int h, const f32x4* v, LAS float* scr, int lane) {
    asm volatile("" : "+s"(idx));
    const TJob j = def_job(p, idx); const int q = lane & 15, rr = lane >> 4, c = lane & 3, nn = lane >> 2;
#pragma unroll
    for (int i = 0; i < 8; ++i) { const int kk = 4 * i + rr; const float s = j.gs ? j.gs[j.k0 + 32 * h + kk] : 1.f; LAS float* d = scr + kk * 65 + 4 * q; const f32x4 w = v[i];
        d[0] = w[0] * s; d[1] = w[1] * s; d[2] = w[2] * s; d[3] = w[3] * s; }
    LDS_WAIT();
#pragma unroll
    for (int jj = 0; jj < 4; ++jj) { const int n = 16 * jj + nn; const LAS float* s = scr + (8 * c) * 65 + n;
        u32x4 o; o.x = pk2(s[0], s[65]); o.y = pk2(s[2 * 65], s[3 * 65]); o.z = pk2(s[4 * 65], s[5 * 65]); o.w = pk2(s[6 * 65], s[7 * 65]);
        *(u32x4*)(j.WT + (size_t)(j.drow0 + n) * j.K + j.k0 + 32 * h + 8 * c) = o; }
    LDS_WAIT();
}

constexpr int SCH = 256, NCH = SEQ / SCH;
#define SSM_ZSEL(w_) do { if (q4 >= 2) { (w_).x = 0u; (w_).y = 0u; (w_).z = 0u; (w_).w = 0u; } } while (0)
#define SSM_BU16(sb) do { const LAS f32x4* up_ = (const LAS f32x4*)(ub + (16 * (sb) + qn) * 16 + 8 * (q4 & 1)); u32x4 aw_ = pack8(up_[0], up_[1]); \
        aw_.x = q4 < 2 ? aw_.x : 0u; aw_.y = q4 < 2 ? aw_.y : 0u; aw_.z = q4 < 2 ? aw_.z : 0u; aw_.w = q4 < 2 ? aw_.w : 0u; const bf16x8 a_ = __builtin_bit_cast(bf16x8, aw_); \
        f32x4 d_[8]; _Pragma("unroll") for (int kb = 0; kb < 8; ++kb) d_[kb] = __builtin_amdgcn_mfma_f32_16x16x32_bf16(a_, Bq[kb], (f32x4){0.f, 0.f, 0.f, 0.f}, 0, 0, 0); \
        _Pragma("unroll") for (int kb = 0; kb < 8; ++kb) _Pragma("unroll") for (int r = 0; r < 4; ++r) xb[(4 * q4 + r) * 132 + 16 * kb + qn] = d_[kb][r]; } while (0)
#define SSM_BC_LOAD() bf16x8 Bq[8]; do { _Pragma("unroll") for (int kb = 0; kb < 8; ++kb) { \
        const f32x4* bp_ = (const f32x4*)((const f32x2*)(ws + WS_BBAR) + (size_t)(g * 64 + 8 * kb + (qn >> 1)) * 16 + 8 * (q4 & 1)); const f32x4 v0_ = bp_[0], v1_ = bp_[1], v2_ = bp_[2], v3_ = bp_[3]; \
        const bool im_ = qn & 1; const f32x4 lo_ = (f32x4){im_ ? v0_[1] : v0_[0], im_ ? v0_[3] : v0_[2], im_ ? v1_[1] : v1_[0], im_ ? v1_[3] : v1_[2]}, hi_ = (f32x4){im_ ? v2_[1] : v2_[0], im_ ? v2_[3] : v2_[2], im_ ? v3_[1] : v3_[0], im_ ? v3_[3] : v3_[2]}; \
        u32x4 bw_ = pack8(lo_, hi_); bw_.x = q4 < 2 ? bw_.x : 0u; bw_.y = q4 < 2 ? bw_.y : 0u; bw_.z = q4 < 2 ? bw_.z : 0u; bw_.w = q4 < 2 ? bw_.w : 0u; Bq[kb] = __builtin_bit_cast(bf16x8, bw_); } } while (0)
#define SSM_GLOAD(s64) do { const float* up = U + (size_t)(b * SEQ + SCH * c + 64 * (s64) + lane) * SWID + 16 * g; a0 = *(const f32x4*)up; a1 = *(const f32x4*)(up + 4); a2 = *(const f32x4*)(up + 8); a3 = *(const f32x4*)(up + 12); } while (0)
#define SSM_LSTORE() do { LAS f32x4* d = (LAS f32x4*)(ub + lane * 16); d[0] = a0; d[1] = a1; d[2] = a2; d[3] = a3; } while (0)

__device__ __forceinline__ void ssm_pass1(const Params& p, LAS unsigned char* lds, int wave, int lane, int G) {
    unsigned char* ws = p.ws; const float* U = (const float*)(ws + WS_U);
    LAS float* ub = (LAS float*)(lds + wave * 12544);
    LAS float* xb = ub + 1024;
    const int gw = blockIdx.x * 8 + wave, NGW = G * 8, qn = lane & 15, q4 = lane >> 4;
    int tslot = NP1 + gw;
    for (int it = gw; it < BATCH * 32 * NCH; it += NGW) {
        const int g = it & 31, c = (it >> 5) & (NCH - 1), b = it >> 10;
        f32x4 a0, a1, a2, a3;
        SSM_GLOAD(0);
        const f32x2 lam = ((const f32x2*)(ws + WS_LAM))[g * 64 + lane];
        SSM_BC_LOAD();
        float xr = 0.f, xi = 0.f;
#pragma unroll 1
        for (int s64 = 0; s64 < 4; ++s64) {
            SSM_LSTORE();
            if (s64 < 3) SSM_GLOAD(s64 + 1);
            const bool has = tslot < NDEFH2; f32x4 tv[8];
            if (has) TILE_ISSUE_HALF(p, tslot >> 1, tslot & 1, tv);
            LDS_WAIT();
#pragma unroll 1
            for (int sub = 0; sub < 4; ++sub) {
                SSM_BU16(sub);
#pragma unroll
                for (int tt = 0; tt < 16; ++tt) { const f32x2 bu = *(const LAS f32x2*)(xb + tt * 132 + 2 * lane);
                    const float nxr = lam.x * xr - lam.y * xi + bu.x, nxi = lam.x * xi + lam.y * xr + bu.y; xr = nxr; xi = nxi; }
            }
            LDS_WAIT();
            if (has) { tile_finish_half(p, tslot >> 1, tslot & 1, tv, xb, lane); tslot += NGW; }
        }
        ((f32x2*)(ws + WS_SLOC))[(size_t)((b * 32 + g) * NCH + c) * 64 + lane] = (f32x2){xr, xi};
    }
    for (; tslot < NDEFH2; tslot += NGW) { f32x4 tv[8]; TILE_ISSUE_HALF(p, tslot >> 1, tslot & 1, tv); tile_finish_half(p, tslot >> 1, tslot & 1, tv, xb, lane); }
}
__device__ __forceinline__ void ssm_pass2(const Params& p, LAS unsigned char* lds, int wave, int lane, int G) {
    unsigned char* ws = p.ws; const float* U = (const float*)(ws + WS_U); bf16* YG = (bf16*)(ws + WS_YG);
    LAS float* ub = (LAS float*)(lds + wave * 12544);
    LAS float* xb = ub + 1024;
    const int gw = blockIdx.x * 8 + wave, NGW = G * 8, qn = lane & 15, q4 = lane >> 4;
    int tslot = NDEFH2 + gw;
    for (int it = gw; it < BATCH * 32 * NCH; it += NGW) {
        const int g = it & 31, c = (it >> 5) & (NCH - 1), b = it >> 10;
        f32x4 a0, a1, a2, a3;
        SSM_GLOAD(0);
        const f32x2 lam = ((const f32x2*)(ws + WS_LAM))[g * 64 + lane], lamT = ((const f32x2*)(ws + WS_LAMT))[g * 64 + lane];
        float xr = 0.f, xi = 0.f;
        { const f32x2* sp = (const f32x2*)(ws + WS_SLOC) + (size_t)((b * 32 + g) * NCH) * 64 + lane;
          f32x2 sv[NCH - 1];
#pragma unroll
          for (int jj = 0; jj < NCH - 1; ++jj) { const int j = c - (NCH - 1) + jj; sv[jj] = j >= 0 ? sp[(size_t)j * 64] : (f32x2){0.f, 0.f}; }
#pragma unroll
          for (int jj = 0; jj < NCH - 1; ++jj) { const float nr = lamT.x * xr - lamT.y * xi + sv[jj].x, ni = lamT.x * xi + lamT.y * xr + sv[jj].y; xr = nr; xi = ni; } }
        SSM_BC_LOAD();
        bf16x8 Cq[4];
        { const float* cre = p.in[10] + (size_t)(g * 16 + qn) * 64; const float* cim = p.in[11] + (size_t)(g * 16 + qn) * 64;
#pragma unroll
          for (int ks = 0; ks < 4; ++ks) { const f32x4 cr = *(const f32x4*)(cre + 16 * ks + 4 * q4), ci = *(const f32x4*)(cim + 16 * ks + 4 * q4);
              Cq[ks] = __builtin_bit_cast(bf16x8, pack8((f32x4){cr[0], -ci[0], cr[1], -ci[1]}, (f32x4){cr[2], -ci[2], cr[3], -ci[3]})); } }
        const float dsk = p.in[12][16 * g + qn];
#pragma unroll 1
        for (int s64 = 0; s64 < 4; ++s64) {
            SSM_LSTORE();
            if (s64 < 3) SSM_GLOAD(s64 + 1);
            const bool has = tslot < NDEFH; f32x4 tv[8];
            if (has) TILE_ISSUE_HALF(p, tslot >> 1, tslot & 1, tv);
            LDS_WAIT();
#pragma unroll 1
            for (int sub = 0; sub < 4; ++sub) {
                SSM_BU16(sub);
#pragma unroll
                for (int tt = 0; tt < 16; ++tt) { LAS f32x2* xp = (LAS f32x2*)(xb + tt * 132 + 2 * lane); const f32x2 bu = *xp;
                    const float nxr = lam.x * xr - lam.y * xi + bu.x, nxi = lam.x * xi + lam.y * xr + bu.y; xr = nxr; xi = nxi; *xp = (f32x2){xr, xi}; }
                f32x4 d = (f32x4){0.f, 0.f, 0.f, 0.f};
                const LAS f32x4* ap = (const LAS f32x4*)(xb + qn * 132 + 8 * q4);
#pragma unroll
                for (int ks = 0; ks < 4; ++ks) d = __builtin_amdgcn_mfma_f32_16x16x32_bf16(__builtin_bit_cast(bf16x8, pack8(ap[8 * ks], ap[8 * ks + 1])), Cq[ks], d, 0, 0, 0);
                f32x4 yv;
#pragma unroll
                for (int r = 0; r < 4; ++r) yv[r] = d[r] + dsk * ub[(16 * sub + 4 * q4 + r) * 16 + qn];
                const f32x4 ygv = gelu4(yv);
                const unsigned w01 = pk2(ygv[0], ygv[1]), w23 = pk2(ygv[2], ygv[3]);
                bf16* yp = YG + (size_t)(b * SEQ + SCH * c + 64 * s64 + 16 * sub + 4 * q4) * SWID + 16 * g + qn;
                yp[0] = (bf16)(w01 & 0xffffu); yp[SWID] = (bf16)(w01 >> 16); yp[2 * SWID] = (bf16)(w23 & 0xffffu); yp[3 * SWID] = (bf16)(w23 >> 16);
            }
            LDS_WAIT();
            if (has) { tile_finish_half(p, tslot >> 1, tslot & 1, tv, xb, lane); tslot += NGW; }
        }
    }
    for (; tslot < NDEFH; tslot += NGW) { f32x4 tv[8]; TILE_ISSUE_HALF(p, tslot >> 1, tslot & 1, tv); tile_finish_half(p, tslot >> 1, tslot & 1, tv, xb, lane); }
}

__global__ void __launch_bounds__(512) mk_fwd(Params p) {
    extern __shared__ __attribute__((aligned(16))) unsigned char lds_raw[];
    LAS unsigned char* lds = (LAS unsigned char*)lds_raw;
    const int tid = threadIdx.x, lane = tid & 63, wave = __builtin_amdgcn_readfirstlane(tid >> 6), G = gridDim.x;
    unsigned char* ws = p.ws;
    const int lo = p.lo, hi = p.hi;
    volatile LAS unsigned* misc = (volatile LAS unsigned*)(lds + MISC_OFF);
    if (tid < 4) misc[tid] = 0u;
    __syncthreads();
    XcdBarrier xbar; xbar.bar = (unsigned*)g_ctl; xbar.x = 0; xbar.st = misc;
    if (!MK_MULTI) xbar = xcd_barrier_post((unsigned*)g_ctl, misc);
#define IN(k) (lo <= (k) && (k) < hi)
#define SEAM(k) do { if (lo <= (k) && (k) + 1 < hi) xcd_barrier(xbar); } while (0)
    if (IN(0)) { REP(0) { p0_prologue(p, lds, tid, wave, lane, G); } SEAM(0); }
#ifdef MK_EXTRA_SYNCS
    for (int i_ = 0; i_ < MK_EXTRA_SYNCS; ++i_) grid.sync();
#endif
    if (IN(1)) { {
        pg8::Gemm g{(const bf16*)(ws + WS_XB), (const bf16*)(ws + WS_WIN), M, INC, DM}; RepOrder S; S.init(M, INC, G, (int)blockIdx.x); S.reps = REPS(1); S.wgm = 4;
        EpiIn E{(const float*)(ws + WS_RSTD1), p.in[3], (bf16*)(ws + WS_Q), (bf16*)(ws + WS_K), (bf16*)(ws + WS_VT), (float*)(ws + WS_U), (bf16*)(ws + WS_G)};
        pg8::gemm_phase<EpiIn, RepOrder, true, true>(lds, g, S, E);
        { const int nwg = (M / 256) * (INC / 256), rem = nwg % G;
          if (rem != 0 && (int)blockIdx.x >= rem) { const int iw = ((int)blockIdx.x - rem) * 8 + wave, niw = (G - rem) * 8; LAS float* scr = (LAS float*)(lds + wave * 8320);
              for (int h = iw; h < NP1; h += niw) { f32x4 tv[8]; TILE_ISSUE_HALF(p, h >> 1, h & 1, tv); tile_finish_half(p, h >> 1, h & 1, tv, scr, lane); } }
          else if (rem == 0) { const int gw = blockIdx.x * 8 + wave; LAS float* scr = (LAS float*)(lds + wave * 8320);
              for (int h = gw; h < NP1; h += G * 8) { f32x4 tv[8]; TILE_ISSUE_HALF(p, h >> 1, h & 1, tv); tile_finish_half(p, h >> 1, h & 1, tv, scr, lane); } } } }
        SEAM(1);
    }
    if (IN(2)) { REP(2) {
        for (int it = blockIdx.x; it < BATCH * 64 * 2; it += G) attn_item(p, lds, it, tid, wave, lane);
        ssm_pass1(p, lds, wave, lane, G); }
        SEAM(2);
    }
    if (IN(3)) { REP(3) { ssm_pass2(p, lds, wave, lane, G); __syncthreads(); } SEAM(3); }
    if (IN(4)) {
        pg8::Gemm g{(const bf16*)(ws + WS_YG), (const bf16*)(ws + WS_WGLU), M, 1024, SWID}; RepOrder S; S.init(M, 1024, G, (int)blockIdx.x); S.reps = REPS(4);
        EpiGlu E{p.in[14], (bf16*)(ws + WS_SSM)};
        pg8::gemm_phase<EpiGlu, RepOrder, true, true>(lds, g, S, E);
        SEAM(4);
    }
    if (IN(5)) {
        { pg8::Gemm g{(const bf16*)(ws + WS_ATT), (const bf16*)(ws + WS_WBA), M, DM, AW}; RepOrder S; S.init(M, DM, G, (int)blockIdx.x); S.reps = REPS(5); S.wgm = 4;
          EpiBrA E{(const bf16*)(ws + WS_G), (bf16*)(ws + WS_XB)};
          pg8::gemm_phase<EpiBrA, RepOrder, true, true>(lds, g, S, E); }
        __syncthreads();
        { pg8::Gemm g{(const bf16*)(ws + WS_SSM), (const bf16*)(ws + WS_WBS), M, DM, SWID}; RepOrder S; S.init(M, DM, G, (int)blockIdx.x); S.reps = REPS(5); S.wgm = 4;
          EpiBrB E{(const bf16*)(ws + WS_G), (const bf16*)(ws + WS_XB), (bf16*)(ws + WS_XB)};
          pg8::gemm_phase<EpiBrB, RepOrder, true, true>(lds, g, S, E); }
        SEAM(5);
    }
    if (IN(6)) {
        pg8::Gemm g{(const bf16*)(ws + WS_XB), (const bf16*)(ws + WS_WOUT), M, DM, DM}; RepOrder S; S.init(M, DM, G, (int)blockIdx.x); S.reps = REPS(6); S.wgm = 4;
        EpiX1 E{p.in[0], (bf16*)(ws + WS_X1B), (float*)(ws + WS_SS2)};
        pg8::gemm_phase<EpiX1, RepOrder, true, true>(lds, g, S, E);
        SEAM(6);
    }
    if (IN(7)) { {
        pg8::Gemm g{(const bf16*)(ws + WS_X1B), (const bf16*)(ws + WS_WUP), M, 2 * DFF, DM}; RepOrder S; S.init(M, 2 * DFF, G, (int)blockIdx.x); S.reps = REPS(7); S.wgm = 4;
        EpiUp E{(const float*)(ws + WS_SS2), p.in[20], p.in[21], (bf16*)(ws + WS_ACT), (float*)(ws + WS_HPREV), (float*)(ws + WS_HG), (float*)(ws + WS_HV)};
        pg8::gemm_phase<EpiUp, RepOrder, true, true>(lds, g, S, E); }
        SEAM(7);
    }
    if (IN(8)) {
        const float* HP = (const float*)(ws + WS_HPREV); const float* HG = (const float*)(ws + WS_HG); const float* HV = (const float*)(ws + WS_HV);
        const float* cw = p.in[20]; const float* cb = p.in[21]; bf16* ACT = (bf16*)(ws + WS_ACT);
        constexpr int NV = 256 * 2 * (DFF / 4);
        for (int i = blockIdx.x * 512 + tid; i < NV; i += G * 512) {
            const int ch = (i % (DFF / 4)) * 4, rr = i / (DFF / 4), fr = rr & 1, grp = rr >> 1;
            const bool hp = (grp & 127) != 0;
            const f32x4 z = (f32x4){0.f, 0.f, 0.f, 0.f};
            const f32x4 g = *(const f32x4*)(HG + (size_t)(grp * 2 + fr) * DFF + ch), v = *(const f32x4*)(HV + (size_t)(grp * 2 + fr) * DFF + ch);
            const f32x4 pm1 = hp ? *(const f32x4*)(HP + (size_t)((grp - 1) * 2 + 1) * DFF + ch) : z;
            const f32x4 pm2 = hp ? *(const f32x4*)(HP + (size_t)((grp - 1) * 2 + 0) * DFF + ch) : z;
            const f32x4 g0 = *(const f32x4*)(HG + (size_t)(grp * 2) * DFF + ch);
            const f32x4 g1 = fr ? g0 : pm1, g2 = fr ? pm1 : pm2;
            const f32x4 w0 = *(const f32x4*)(cw + ch), w1 = *(const f32x4*)(cw + DFF + ch), w2 = *(const f32x4*)(cw + 2 * DFF + ch), bb = *(const f32x4*)(cb + ch);
            const f32x4 a = v * gelu4(bb + w0 * g2 + w1 * g1 + w2 * g);
            u32x2 w; w.x = pk2(a[0], a[1]); w.y = pk2(a[2], a[3]); *(u32x2*)(ACT + (size_t)(grp * 64 + fr) * DFF + ch) = w;
        }
        SEAM(8);
    }
    if (IN(9)) {
        pg8::Gemm g{(const bf16*)(ws + WS_ACT), (const bf16*)(ws + WS_WDN), M, DM, DFF}; RepOrder S; S.init(M, DM, G, (int)blockIdx.x); S.reps = REPS(9); S.wgm = 4;
        EpiX2 E{(const bf16*)(ws + WS_X1B), (bf16*)(ws + WS_XB), (float*)(ws + WS_SS3)};
        pg8::gemm_phase<EpiX2, RepOrder, true, true>(lds, g, S, E);
        SEAM(9);
    }
    if (IN(10)) {
        const float* ss3 = (const float*)(ws + WS_SS3); const float* gf = p.in[23];
        const int gw = blockIdx.x * 8 + wave, NGW = G * 8;
        f32x4 gv[8];
#pragma unroll
        for (int j = 0; j < 8; ++j) gv[j] = ((const f32x4*)gf)[lane + 64 * j];
        const bf16* X2B = (const bf16*)(ws + WS_XB);
        for (int m = gw; m < M; m += NGW) {
            const float rs = rsqrtf(ss3[m] * (1.f / DM) + EPS);
            const u32x2* xr = (const u32x2*)(X2B + (size_t)m * DM) + lane;
            f32x4* orow = (f32x4*)(p.out + (size_t)m * DM) + lane;
            u32x2 w[8];
#pragma unroll
            for (int j = 0; j < 8; ++j) w[j] = __builtin_nontemporal_load(xr + 64 * j);
#pragma unroll
            for (int j = 0; j < 8; ++j) { const f32x4 v = (f32x4){__uint_as_float(w[j].x << 16), __uint_as_float(w[j].x & 0xffff0000u), __uint_as_float(w[j].y << 16), __uint_as_float(w[j].y & 0xffff0000u)};
                __builtin_nontemporal_store(v * rs * gv[j], orow + 64 * j); }
        }
    }
    if (!MK_MULTI && wave == 0) { unsigned old_ = 0u; if (lane == 0) old_ = xb_add((unsigned*)g_ctl + CTL_EXIT, 1u); old_ = (unsigned)__shfl((int)old_, 0);
        if (old_ == (unsigned)G - 1u) {
            int w_ = -1;
            if (lane < 16) w_ = XB_XCNT(lane); else if (lane < 32) w_ = XB_XSUB(lane - 16); else if (lane < 48) w_ = XB_XGEN(lane - 32);
            else if (lane == 48) w_ = XB_TMO; else if (lane == 49) w_ = XB_TOP; else if (lane == 50) w_ = XB_TOPGEN; else if (lane == 51) w_ = CTL_EXIT;
            if (w_ >= 0) __hip_atomic_store((unsigned*)g_ctl + w_, 0u, __ATOMIC_RELAXED, __HIP_MEMORY_SCOPE_AGENT); } }
#undef IN
#undef SEAM
}

extern "C" void kernel_launch(void* const* d_in, const int* in_sizes, int n_in, void* d_out, int out_size, void* d_ws, size_t ws_size, hipStream_t stream) {
    static int grid = 0;
    if (grid == 0) {
        if (n_in != 24 || out_size != M * DM || ws_size < WS_END) { fprintf(stderr, "kernel_launch: unexpected shapes (n_in %d out %d ws %zu)\n", n_in, out_size, ws_size); grid = -1; return; }
        int dev = 0, cus = 0, per_cu = 0;
        hipGetDevice(&dev); hipDeviceGetAttribute(&cus, hipDeviceAttributeMultiprocessorCount, dev);
        if (hipFuncSetAttribute((const void*)mk_fwd, hipFuncAttributeMaxDynamicSharedMemorySize, LDS_BYTES) != hipSuccess) { fprintf(stderr, "kernel_launch: hipFuncSetAttribute failed\n"); grid = -1; return; }
        if (hipOccupancyMaxActiveBlocksPerMultiprocessor(&per_cu, (const void*)mk_fwd, 512, LDS_BYTES) != hipSuccess || per_cu < 1) { fprintf(stderr, "kernel_launch: occupancy query says %d blocks per CU\n", per_cu); per_cu = 1; }
        (void)hipGetLastError();
        grid = cus;
    }
    if (grid < 0) return;
    Params a{};
    for (int i = 0; i < 24; ++i) a.in[i] = (const float*)d_in[i];
    a.out = (float*)d_out; a.ws = (unsigned char*)d_ws;
#if MK_MULTI
    for (int ph = 0; ph < NPH; ++ph) { a.lo = ph; a.hi = ph + 1; hipLaunchKernelGGL(mk_fwd, dim3(grid), dim3(512), LDS_BYTES, stream, a); }
#else
    a.lo = 0; a.hi = NPH;
    void* args[] = {&a};
    hipError_t e = hipLaunchCooperativeKernel((const void*)mk_fwd, dim3(grid), dim3(512), args, LDS_BYTES, stream);
    if (e != hipSuccess) fprintf(stderr, "kernel_launch: cooperative launch failed: %s (grid %d)\n", hipGetErrorString(e), grid);
#endif
}
```
